# Optimizing an MI355X kernel written in HIP

```python
import math
import jax
import jax.numpy as jnp
from jax import lax
import numpy as np

D_MODEL = 1024
BATCH = 8
SEQ = 4096
DEPTH = 2

CHUNK = 64
N_EVEN = (DEPTH + 1) // 2
N_ODD = DEPTH // 2
RMS_EPS = 1e-6

S5_WIDTH = D_MODEL // 2
S5_GROUP = 16
S5_GROUPS = S5_WIDTH // S5_GROUP
S5_STATE = 64
SB_HEAD_DIM = 64
SB_WIDTH = D_MODEL // 2
SB_HEADS = SB_WIDTH // SB_HEAD_DIM
SB_QBLOCK = 128
EVEN_IN = S5_WIDTH + 3 * SB_WIDTH
EVEN_MIX = S5_WIDTH + SB_WIDTH

RW_WIDTH = D_MODEL // 2
RW_HEAD = 64
RW_HEADS = RW_WIDTH // RW_HEAD
RW_DECAY_LORA = 64
RW_AAA_LORA = 64
RW_GATE_LORA = 128
RW_IN = 3 * RW_WIDTH + RW_DECAY_LORA + RW_AAA_LORA + RW_GATE_LORA
RW_LN_EPS = 64e-5

M2_INNER = D_MODEL // 2
M2_HEADDIM = 64
M2_HEADS = M2_INNER // M2_HEADDIM
M2_GROUPS = 2
M2_STATE = 128
M2_CONV = 4
M2_CONV_DIM = M2_INNER + 2 * M2_GROUPS * M2_STATE
M2_IN = M2_INNER + M2_CONV_DIM + M2_HEADS
ODD_IN = RW_IN + M2_IN
ODD_MIX = RW_WIDTH + M2_INNER

MOE_GROUPS = 4
MOE_PER_GROUP = 8
MOE_EXPERTS = MOE_GROUPS * MOE_PER_GROUP
MOE_TOPK = 2
MOE_HIDDEN = 512
MOE_BLOCK = 128

kernel_name = 'hybrid_s5_stickbreak_rwkv7_ssd_hmoe'


def rmsnorm(x, w):
    xf = x.astype(jnp.float32)
    xf = xf * lax.rsqrt(jnp.mean(xf * xf, axis=-1, keepdims=True) + RMS_EPS)
    return xf.astype(x.dtype) * w


def modulate(h, shift, scale):
    return h * (1.0 + scale[:, None, :]) + shift[:, None, :]


def token_shift(z):
    return jnp.pad(z[:, :-1], ((0, 0), (1, 0), (0, 0)))


def _cmul(ar, ai, br, bi):
    return ar * br - ai * bi, ar * bi + ai * br


def s5_mixer(u, a_re, a_im, log_dt, b_re, b_im, c_re, c_im, d_skip, w_glu):
    f32 = jnp.float32
    bsz, seq, _ = u.shape
    a_re = jnp.minimum(a_re.astype(f32), -1e-4)
    a_im = a_im.astype(f32)
    dt = jnp.exp(log_dt.astype(f32))[:, None]
    mag = jnp.exp(dt * a_re)
    abar_re, abar_im = mag * jnp.cos(dt * a_im), mag * jnp.sin(dt * a_im)
    den = a_re * a_re + a_im * a_im
    num_re, num_im = abar_re - 1.0, abar_im
    coef_re = (num_re * a_re + num_im * a_im) / den
    coef_im = (num_im * a_re - num_re * a_im) / den
    bb_re, bb_im = _cmul(coef_re[..., None], coef_im[..., None], b_re.astype(f32), b_im.astype(f32))
    c_re = c_re.astype(f32)
    c_im = c_im.astype(f32)
    d_skip = d_skip.astype(f32)
    n_chunks = seq // CHUNK
    uc = u.astype(f32).reshape(bsz, n_chunks, CHUNK, S5_GROUPS, S5_GROUP).transpose(1, 0, 2, 3, 4)

    def combine(e1, e2):
        ar1, ai1, br1, bi1 = e1
        ar2, ai2, br2, bi2 = e2
        ar, ai = _cmul(ar2, ai2, ar1, ai1)
        tr, ti = _cmul(ar2, ai2, br1, bi1)
        return ar, ai, tr + br2, ti + bi2

    def chunk_step(carry, u_c):
        h_re, h_im = carry
        bu_re = jnp.einsum('blgp,gnp->blgn', u_c, bb_re)
        bu_im = jnp.einsum('blgp,gnp->blgn', u_c, bb_im)
        ar = jnp.broadcast_to(abar_re, bu_re.shape)
        ai = jnp.broadcast_to(abar_im, bu_re.shape)
        pa_re, pa_im, s_re, s_im = lax.associative_scan(combine, (ar, ai, bu_re, bu_im), axis=1)
        cr, ci = _cmul(pa_re, pa_im, h_re[:, None], h_im[:, None])
        s_re = s_re + cr
        s_im = s_im + ci
        y = (jnp.einsum('blgn,gpn->blgp', s_re, c_re)
             - jnp.einsum('blgn,gpn->blgp', s_im, c_im)
             + d_skip * u_c)
        return (s_re[:, -1], s_im[:, -1]), y

    zeros = jnp.zeros((bsz, S5_GROUPS, S5_STATE), f32)
    _, ys = lax.scan(chunk_step, (zeros, zeros), uc)
    y = jax.nn.gelu(ys.transpose(1, 0, 2, 3, 4).reshape(bsz, seq, S5_WIDTH)).astype(u.dtype)
    g = y @ w_glu
    return g[..., :S5_WIDTH] * jax.nn.sigmoid(g[..., S5_WIDTH:])


def stick_breaking_attention(q, k, v):
    seq = q.shape[1]
    q, k, v = (jnp.swapaxes(z, 1, 2) for z in (q, k, v))
    scale = SB_HEAD_DIM ** -0.5
    outs = []
    for blk in range(seq // SB_QBLOCK):
        s0 = blk * SB_QBLOCK
        s1 = s0 + SB_QBLOCK
        z = jnp.einsum('bhqd,bhkd->bhqk', q[:, :, s0:s1], k[:, :, :s1]).astype(jnp.float32) * scale
        mask = jnp.arange(s1)[None, :] < jnp.arange(s0, s1)[:, None]
        log_keep = jnp.where(mask, jax.nn.log_sigmoid(-z), 0.0)
        rc = lax.cumsum(log_keep, axis=3, reverse=True)
        suffix = jnp.concatenate([rc[..., 1:], jnp.zeros_like(rc[..., :1])], axis=-1)
        w = jnp.where(mask, jnp.exp(jax.nn.log_sigmoid(z) + suffix), 0.0)
        outs.append(jnp.einsum('bhqk,bhkd->bhqd', w.astype(v.dtype), v[:, :, :s1]))
    return jnp.swapaxes(jnp.concatenate(outs, axis=2), 1, 2)


def even_mixer(h, w_in, w_out, a_re, a_im, log_dt, b_re, b_im, c_re, c_im, d_skip, w_glu):
    bsz, seq, _ = h.shape
    proj = h @ w_in
    u = proj[..., :S5_WIDTH]
    q, k, v = (proj[..., S5_WIDTH + i * SB_WIDTH:S5_WIDTH + (i + 1) * SB_WIDTH]
               .reshape(bsz, seq, SB_HEADS, SB_HEAD_DIM) for i in range(3))
    y_a = s5_mixer(u, a_re, a_im, log_dt, b_re, b_im, c_re, c_im, d_skip, w_glu)
    y_b = stick_breaking_attention(q, k, v).reshape(bsz, seq, SB_WIDTH)
    return jnp.concatenate([y_a, y_b], axis=-1) @ w_out


def rwkv7_recurrence(r, decay, k, v, a, b):
    bsz, _, heads, n = r.shape

    def step(state, inp):
        r_t, d_t, k_t, v_t, a_t, b_t = inp
        sa = jnp.einsum('bhvk,bhk->bhv', state, a_t)
        state = (state * d_t[:, :, None, :] + sa[..., None] * b_t[:, :, None, :]
                 + v_t[..., None] * k_t[:, :, None, :])
        return state, jnp.einsum('bhvk,bhk->bhv', state, r_t)

    xs = tuple(jnp.swapaxes(z, 0, 1) for z in (r, decay, k, v, a, b))
    _, ys = lax.scan(step, jnp.zeros((bsz, heads, n, n), jnp.float32), xs)
    return jnp.swapaxes(ys, 0, 1)


def rwkv7_mixer(p, mu, w0, w2, a0, a2, g2, k_k, k_a, r_k, ln_w, ln_b):
    bsz, seq, _ = p.shape
    p = p + (token_shift(p) - p) * mu
    i1, i2, i3 = RW_WIDTH, 2 * RW_WIDTH, 3 * RW_WIDTH
    i4 = i3 + RW_DECAY_LORA
    i5 = i4 + RW_AAA_LORA
    r, k, v, xw, xa, xg = jnp.split(p.astype(jnp.float32), [i1, i2, i3, i4, i5], axis=-1)
    w = -jax.nn.softplus(-(w0 + jnp.tanh(xw) @ w2)) - 0.5
    decay = jnp.exp(-jnp.exp(w))
    a = jax.nn.sigmoid(a0 + xa @ a2)
    g = jax.nn.sigmoid(xg) @ g2

    def heads(z):
        return z.reshape(bsz, seq, RW_HEADS, RW_HEAD)

    kk = heads(k * k_k)
    kk = kk / jnp.maximum(jnp.linalg.norm(kk, axis=-1, keepdims=True), 1e-12)
    k = k * (1.0 + (a - 1.0) * k_a)
    r_h, k_h, v_h, a_h = heads(r), heads(k), heads(v), heads(a)
    y = rwkv7_recurrence(r_h, heads(decay), k_h, v_h, -kk, kk * a_h)
    mean = jnp.mean(y, axis=-1, keepdims=True)
    var = jnp.mean(jnp.square(y - mean), axis=-1, keepdims=True)
    y = ((y - mean) * lax.rsqrt(var + RW_LN_EPS)).reshape(bsz, seq, RW_WIDTH) * ln_w + ln_b
    bonus = jnp.sum(r_h * k_h * r_k, axis=-1, keepdims=True) * v_h
    y = (y + bonus.reshape(bsz, seq, RW_WIDTH)) * g
    return y.astype(p.dtype)


def causal_dwconv(x, w, b):
    width, ch = w.shape
    y = lax.conv_general_dilated(x, w[:, None, :].astype(x.dtype), window_strides=(1,),
                                 padding=[(width - 1, 0)],
                                 dimension_numbers=('NWC', 'WIO', 'NWC'),
                                 feature_group_count=ch)
    return y + b


def segsum(z):
    n = z.shape[-1]
    cs = jnp.cumsum(z, axis=-1)
    diff = cs[..., :, None] - cs[..., None, :]
    return jnp.where(jnp.tril(jnp.ones((n, n), bool)), diff, -jnp.inf)


def ssd_chunked(x, dt, a, bm, cm):
    bsz, seq, nh, hp = x.shape
    n_chunks = seq // CHUNK
    xd = (x * dt[..., None]).reshape(bsz, n_chunks, CHUNK, nh, hp)
    a_dt = (a * dt).reshape(bsz, n_chunks, CHUNK, nh).transpose(0, 3, 1, 2)
    bc = bm.reshape(bsz, n_chunks, CHUNK, nh, -1)
    cc = cm.reshape(bsz, n_chunks, CHUNK, nh, -1)
    a_cs = jnp.cumsum(a_dt, axis=-1)
    l_mat = jnp.exp(segsum(a_dt))
    y_diag = jnp.einsum('bclhn,bcshn,bhcls,bcshp->bclhp', cc, bc, l_mat, xd)
    decay_states = jnp.exp(a_cs[..., -1:] - a_cs)
    states = jnp.einsum('bclhn,bhcl,bclhp->bchpn', bc, decay_states, xd)
    states = jnp.concatenate([jnp.zeros_like(states[:, :1]), states], axis=1)
    decay_chunk = jnp.exp(segsum(jnp.pad(a_cs[..., -1], ((0, 0), (0, 0), (1, 0)))))
    states = jnp.einsum('bhzc,bchpn->bzhpn', decay_chunk, states)[:, :-1]
    y_off = jnp.einsum('bclhn,bchpn,bhcl->bclhp', cc, states, jnp.exp(a_cs))
    return (y_diag + y_off).reshape(bsz, seq, nh, hp)


def mamba2_mixer(p, conv_w, conv_b, dt_bias, a_log, d_skip, norm_w):
    f32 = jnp.float32
    bsz, seq, _ = p.shape
    z = p[..., :M2_INNER]
    xbc = jax.nn.silu(causal_dwconv(p[..., M2_INNER:M2_INNER + M2_CONV_DIM], conv_w, conv_b))
    dt_raw = p[..., M2_INNER + M2_CONV_DIM:]
    xs = xbc[..., :M2_INNER].astype(f32).reshape(bsz, seq, M2_HEADS, M2_HEADDIM)
    heads_per_group = M2_HEADS // M2_GROUPS
    bm = xbc[..., M2_INNER:M2_INNER + M2_GROUPS * M2_STATE].astype(f32).reshape(bsz, seq, M2_GROUPS, M2_STATE)
    cm = xbc[..., M2_INNER + M2_GROUPS * M2_STATE:].astype(f32).reshape(bsz, seq, M2_GROUPS, M2_STATE)
    bm = jnp.repeat(bm, heads_per_group, axis=2)
    cm = jnp.repeat(cm, heads_per_group, axis=2)
    dt = jax.nn.softplus(dt_raw.astype(f32) + dt_bias.astype(f32))
    a = -jnp.exp(a_log.astype(f32))
    y = ssd_chunked(xs, dt, a, bm, cm) + d_skip.astype(f32)[:, None] * xs
    y = y.reshape(bsz, seq, M2_INNER) * jax.nn.silu(z.astype(f32))
    yg = y.reshape(bsz, seq, M2_GROUPS, M2_INNER // M2_GROUPS)
    yg = yg * lax.rsqrt(jnp.mean(yg * yg, axis=-1, keepdims=True) + RMS_EPS)
    return (yg.reshape(bsz, seq, M2_INNER) * norm_w).astype(p.dtype)


def odd_mixer(h, w_in, w_out, rw_mu, rw_w0, rw_w2, rw_a0, rw_a2, rw_g2, rw_k_k, rw_k_a,
              rw_r_k, rw_ln_w, rw_ln_b, m2_conv_w, m2_conv_b, m2_dt_bias, m2_a_log, m2_d, m2_norm_w):
    proj = h @ w_in
    y_c = rwkv7_mixer(proj[..., :RW_IN], rw_mu, rw_w0, rw_w2, rw_a0, rw_a2, rw_g2,
                      rw_k_k, rw_k_a, rw_r_k, rw_ln_w, rw_ln_b)
    y_d = mamba2_mixer(proj[..., RW_IN:], m2_conv_w, m2_conv_b, m2_dt_bias, m2_a_log, m2_d, m2_norm_w)
    return jnp.concatenate([y_c, y_d], axis=-1) @ w_out


def routed_experts(t, expert_idx, gates, w_gate, w_up, w_down):
    n_tok, d = t.shape
    n_assign = n_tok * MOE_TOPK
    flat_e = expert_idx.reshape(-1)
    flat_tok = jnp.repeat(jnp.arange(n_tok, dtype=jnp.int32), MOE_TOPK)
    flat_g = gates.reshape(-1)
    order = jnp.argsort(flat_e)
    sorted_e = flat_e[order]
    counts = jnp.bincount(flat_e, length=MOE_EXPERTS)
    padded = ((counts + MOE_BLOCK - 1) // MOE_BLOCK) * MOE_BLOCK
    pad_end = jnp.cumsum(padded)
    pad_start = pad_end - padded
    start = jnp.cumsum(counts) - counts
    dest = pad_start[sorted_e] + jnp.arange(n_assign) - start[sorted_e]
    n_blocks = (n_assign + MOE_EXPERTS * (MOE_BLOCK - 1) + MOE_BLOCK - 1) // MOE_BLOCK
    n_rows = n_blocks * MOE_BLOCK
    row_tok = jnp.full((n_rows,), n_tok, jnp.int32).at[dest].set(flat_tok[order])
    row_gate = jnp.zeros((n_rows,), jnp.float32).at[dest].set(flat_g[order])
    blk_expert = jnp.minimum(jnp.searchsorted(pad_end, jnp.arange(n_blocks) * MOE_BLOCK, side='right'),
                             MOE_EXPERTS - 1)
    t_pad = jnp.concatenate([t, jnp.zeros((1, d), t.dtype)], axis=0)
    xs = t_pad[row_tok].reshape(n_blocks, MOE_BLOCK, d)

    def expert_block(args):
        xb, e = args
        return (jax.nn.silu(xb @ w_gate[e]) * (xb @ w_up[e])) @ w_down[e]

    ys = lax.map(expert_block, (xs, blk_expert)).reshape(n_rows, d)
    out = jnp.zeros((n_tok + 1, d), ys.dtype).at[row_tok].add(ys * row_gate[:, None].astype(ys.dtype))
    return out[:n_tok]


def hierarchical_moe(h, w_grp, b_grp, w_exp, b_exp, w_gate, w_up, w_down):
    bsz, seq, d = h.shape
    t = h.reshape(-1, d)
    n_tok = t.shape[0]
    grp_prob = jax.nn.softmax((t @ w_grp + b_grp).astype(jnp.float32), axis=-1)
    grp_p, grp_idx = lax.top_k(grp_prob, 1)
    exp_logits = (t @ w_exp + b_exp).astype(jnp.float32).reshape(n_tok, MOE_GROUPS, MOE_PER_GROUP)
    in_grp = exp_logits[jnp.arange(n_tok), grp_idx[:, 0]]
    top_logit, top_local = lax.top_k(in_grp, MOE_TOPK)
    gates = grp_p * jax.nn.softmax(top_logit, axis=-1)
    expert_idx = grp_idx * MOE_PER_GROUP + top_local
    return routed_experts(t, expert_idx, gates, w_gate, w_up, w_down).reshape(bsz, seq, d)


def setup_inputs(seed: int = 0) -> dict:
    key = jax.random.key(seed)
    ks = iter(jax.random.split(key, 64))
    f32 = jnp.float32
    D = D_MODEL

    def nrm(shape, scale):
        return scale * jax.random.normal(next(ks), shape, f32)

    def uni(shape, lo, hi):
        return jax.random.uniform(next(ks), shape, f32, lo, hi)

    log_dt_lo, log_dt_hi = math.log(1e-3), math.log(1e-1)
    m2_dt = jnp.exp(uni((N_ODD, M2_HEADS), log_dt_lo, log_dt_hi))
    return {
        'x': nrm((BATCH, SEQ, D), 1.0),
        'c': nrm((BATCH, D), 1.0),
        'ada_w': nrm((DEPTH, D, 6 * D), 0.5 * D ** -0.5),
        'ada_b': nrm((DEPTH, 6 * D), 0.02),
        'norm_mix_w': 1.0 + nrm((DEPTH, D), 0.05),
        'norm_ffn_w': 1.0 + nrm((DEPTH, D), 0.05),
        'even_w_in': nrm((N_EVEN, D, EVEN_IN), D ** -0.5),
        'even_w_out': nrm((N_EVEN, EVEN_MIX, D), EVEN_MIX ** -0.5),
        's5_a_re': -0.5 + nrm((N_EVEN, S5_GROUPS, S5_STATE), 0.01),
        's5_a_im': math.pi * jnp.arange(S5_STATE, dtype=f32)[None, None, :] + nrm((N_EVEN, S5_GROUPS, S5_STATE), 0.01),
        's5_log_dt': uni((N_EVEN, S5_GROUPS), log_dt_lo, log_dt_hi),
        's5_b_re': nrm((N_EVEN, S5_GROUPS, S5_STATE, S5_GROUP), (2 * S5_GROUP) ** -0.5),
        's5_b_im': nrm((N_EVEN, S5_GROUPS, S5_STATE, S5_GROUP), (2 * S5_GROUP) ** -0.5),
        's5_c_re': nrm((N_EVEN, S5_GROUPS, S5_GROUP, S5_STATE), S5_STATE ** -0.5),
        's5_c_im': nrm((N_EVEN, S5_GROUPS, S5_GROUP, S5_STATE), S5_STATE ** -0.5),
        's5_d': nrm((N_EVEN, S5_GROUPS, S5_GROUP), 1.0),
        's5_w_glu': nrm((N_EVEN, S5_WIDTH, 2 * S5_WIDTH), S5_WIDTH ** -0.5),
        'odd_w_in': nrm((N_ODD, D, ODD_IN), D ** -0.5),
        'odd_w_out': nrm((N_ODD, ODD_MIX, D), ODD_MIX ** -0.5),
        'rw_mu': uni((N_ODD, RW_IN), 0.0, 1.0),
        'rw_w0': uni((N_ODD, RW_WIDTH), -5.0, 0.0),
        'rw_w2': nrm((N_ODD, RW_DECAY_LORA, RW_WIDTH), 0.1),
        'rw_a0': nrm((N_ODD, RW_WIDTH), 0.1),
        'rw_a2': nrm((N_ODD, RW_AAA_LORA, RW_WIDTH), 0.1),
        'rw_g2': nrm((N_ODD, RW_GATE_LORA, RW_WIDTH), RW_GATE_LORA ** -0.5),
        'rw_k_k': 0.85 + nrm((N_ODD, RW_WIDTH), 0.02),
        'rw_k_a': 1.0 + nrm((N_ODD, RW_WIDTH), 0.02),
        'rw_r_k': nrm((N_ODD, RW_HEADS, RW_HEAD), 0.1),
        'rw_ln_w': 1.0 + nrm((N_ODD, RW_WIDTH), 0.05),
        'rw_ln_b': nrm((N_ODD, RW_WIDTH), 0.02),
        'm2_conv_w': nrm((N_ODD, M2_CONV, M2_CONV_DIM), M2_CONV ** -0.5),
        'm2_conv_b': nrm((N_ODD, M2_CONV_DIM), 0.02),
        'm2_dt_bias': m2_dt + jnp.log(-jnp.expm1(-m2_dt)),
        'm2_a_log': jnp.log(uni((N_ODD, M2_HEADS), 1.0, 16.0)),
        'm2_d': 1.0 + nrm((N_ODD, M2_HEADS), 0.1),
        'm2_norm_w': 1.0 + nrm((N_ODD, M2_INNER), 0.05),
        'moe_w_grp': nrm((DEPTH, D, MOE_GROUPS), D ** -0.5),
        'moe_b_grp': nrm((DEPTH, MOE_GROUPS), 0.01),
        'moe_w_exp': nrm((DEPTH, D, MOE_EXPERTS), D ** -0.5),
        'moe_b_exp': nrm((DEPTH, MOE_EXPERTS), 0.01),
        'moe_w_gate': nrm((DEPTH, MOE_EXPERTS, D, MOE_HIDDEN), D ** -0.5),
        'moe_w_up': nrm((DEPTH, MOE_EXPERTS, D, MOE_HIDDEN), D ** -0.5),
        'moe_w_down': nrm((DEPTH, MOE_EXPERTS, MOE_HIDDEN, D), MOE_HIDDEN ** -0.5),
        'final_norm_w': 1.0 + nrm((D,), 0.05),
    }


def reference(x, c, ada_w, ada_b, norm_mix_w, norm_ffn_w, even_w_in, even_w_out,
              s5_a_re, s5_a_im, s5_log_dt, s5_b_re, s5_b_im, s5_c_re, s5_c_im, s5_d, s5_w_glu,
              odd_w_in, odd_w_out, rw_mu, rw_w0, rw_w2, rw_a0, rw_a2, rw_g2, rw_k_k, rw_k_a,
              rw_r_k, rw_ln_w, rw_ln_b, m2_conv_w, m2_conv_b, m2_dt_bias, m2_a_log, m2_d, m2_norm_w,
              moe_w_grp, moe_b_grp, moe_w_exp, moe_b_exp, moe_w_gate, moe_w_up, moe_w_down,
              final_norm_w):
    cond = jax.nn.silu(c)
    for i in range(DEPTH):
        j = i // 2
        shift1, scale1, gate1, shift2, scale2, gate2 = jnp.split(cond @ ada_w[i] + ada_b[i], 6, axis=-1)
        h = modulate(rmsnorm(x, norm_mix_w[i]), shift1, scale1)
        if i % 2 == 0:
            y = even_mixer(h, even_w_in[j], even_w_out[j], s5_a_re[j], s5_a_im[j], s5_log_dt[j],
                           s5_b_re[j], s5_b_im[j], s5_c_re[j], s5_c_im[j], s5_d[j], s5_w_glu[j])
        else:
            y = odd_mixer(h, odd_w_in[j], odd_w_out[j], rw_mu[j], rw_w0[j], rw_w2[j], rw_a0[j],
                          rw_a2[j], rw_g2[j], rw_k_k[j], rw_k_a[j], rw_r_k[j], rw_ln_w[j], rw_ln_b[j],
                          m2_conv_w[j], m2_conv_b[j], m2_dt_bias[j], m2_a_log[j], m2_d[j], m2_norm_w[j])
        x = x + gate1[:, None, :] * y
        h = modulate(rmsnorm(x, norm_ffn_w[i]), shift2, scale2)
        x = x + gate2[:, None, :] * hierarchical_moe(h, moe_w_grp[i], moe_b_grp[i], moe_w_exp[i], moe_b_exp[i],
                                                     moe_w_gate[i], moe_w_up[i], moe_w_down[i])
    return rmsnorm(x, final_norm_w)
```

```cpp
#include <hip/hip_runtime.h>
#include <hip/hip_cooperative_groups.h>
#include <stdint.h>
#include <stdio.h>

typedef unsigned short bf16_t;
typedef __attribute__((ext_vector_type(8))) short bf16x8;
typedef __attribute__((ext_vector_type(4))) float f32x4;
typedef __attribute__((ext_vector_type(4))) unsigned u32x4;
typedef __attribute__((ext_vector_type(2))) unsigned u32x2;

#define DEVINL __device__ __forceinline__

constexpr int D = 1024, BATCH = 8, SEQ = 4096, T = BATCH * SEQ;
constexpr int NSLOT = 73728;

enum { I_X = 0, I_C, I_ADA_W, I_ADA_B, I_NORM_MIX, I_NORM_FFN, I_EVEN_WIN, I_EVEN_WOUT, I_S5_ARE, I_S5_AIM, I_S5_LOGDT,
       I_S5_BRE, I_S5_BIM, I_S5_CRE, I_S5_CIM, I_S5_D, I_S5_WGLU, I_ODD_WIN, I_ODD_WOUT, I_RW_MU, I_RW_W0, I_RW_W2,
       I_RW_A0, I_RW_A2, I_RW_G2, I_RW_KK, I_RW_KA, I_RW_RK, I_RW_LNW, I_RW_LNB, I_M2_CONVW, I_M2_CONVB, I_M2_DTB,
       I_M2_ALOG, I_M2_D, I_M2_NORMW, I_MOE_WGRP, I_MOE_BGRP, I_MOE_WEXP, I_MOE_BEXP, I_MOE_WGATE, I_MOE_WUP,
       I_MOE_WDOWN, I_FINAL_W, N_IN };

struct Params {
  const float* in[N_IN];
  float* out;
  char* ws;
};

constexpr size_t OFF_CTL    = 0;
constexpr size_t OFF_MOD    = 65536;
constexpr size_t OFF_WIN0   = OFF_MOD + 393216;
constexpr size_t OFF_WGLU   = OFF_WIN0 + 4194304;
constexpr size_t OFF_WOUT0  = OFF_WGLU + 1048576;
constexpr size_t OFF_WIN1   = OFF_WOUT0 + 2097152;
constexpr size_t OFF_WOUT1  = OFF_WIN1 + 7340032;
constexpr size_t OFF_W2T    = OFF_WOUT1 + 2097152;
constexpr size_t OFF_A2T    = OFF_W2T + 65536;
constexpr size_t OFF_G2T    = OFF_A2T + 65536;
constexpr size_t OFF_S5K    = OFF_G2T + 131072;
constexpr size_t OFF_S5F    = OFF_S5K + 1179648;
constexpr size_t OFF_S5E    = OFF_S5F + 8388608;
constexpr size_t OFF_S5P    = OFF_S5E + 8388608;
constexpr size_t OFF_RWT    = OFF_S5P + 16384;
constexpr size_t OFF_ROUTE  = OFF_RWT + 393216;
constexpr size_t OFF_DTRAW  = OFF_ROUTE + 786432;
constexpr size_t OFF_DTV    = OFF_DTRAW + 1048576;
constexpr size_t OFF_MOEW   = OFF_DTV + 1048576;
constexpr size_t OFF_H      = OFF_MOEW + 100663296;
constexpr size_t OFF_PROJ   = OFF_H + 67108864;
constexpr size_t OFF_MIX    = OFF_PROJ + 226492416;
constexpr size_t OFF_SCR    = OFF_MIX + 67108864;
constexpr size_t OFF_LIST   = OFF_MIX;
constexpr size_t SCR_BYTES  = 117440512;
constexpr size_t WS_NEEDED  = OFF_SCR + SCR_BYTES;
static_assert(WS_NEEDED <= 621250048ull, "workspace is exactly the sum of the inputs");
constexpr size_t OFF_PROJ0  = OFF_PROJ;
constexpr size_t OFF_YS     = OFF_PROJ + 134217728;
constexpr size_t OFF_HLOC   = OFF_PROJ + 167772160;
constexpr size_t OFF_HPREV  = OFF_PROJ + 176160768;
constexpr size_t OFF_PROJR  = OFF_PROJ;
constexpr size_t OFF_PROJM  = OFF_PROJ + 117440512;
constexpr size_t OFF_ACT    = OFF_PROJ;
constexpr size_t OFF_YEXP   = OFF_PROJ + 75497472;
constexpr size_t OFF_WGU    = OFF_MOEW;
constexpr size_t OFF_WD     = OFF_MOEW + 67108864;
constexpr size_t OFF_XBC    = OFF_H;
constexpr size_t OFF_RG     = OFF_H;
constexpr size_t OFF_RKK    = OFF_MOEW;
constexpr size_t OFF_RA     = OFF_MOEW + 33554432;
constexpr size_t OFF_RWE    = OFF_MOEW + 2 * 33554432;
constexpr size_t OFF_XR1    = OFF_SCR;
constexpr size_t OFF_RKP    = OFF_SCR;
constexpr size_t OFF_LORAW  = OFF_SCR + 33554432;
constexpr size_t OFF_LORAA  = OFF_LORAW + 4194304;
constexpr size_t OFF_LORAG  = OFF_LORAA + 4194304;
constexpr size_t OFF_LAM    = OFF_LORAW;
constexpr size_t OFF_ST     = OFF_SCR + 50331648;
constexpr size_t OFF_ATOT   = OFF_DTRAW;
constexpr int YREC_LD = 1024;
constexpr int CTL_COUNT = 9216;
constexpr int CTL_CURSOR = 8320;
constexpr int CTL_SUBBAR = 8448;
constexpr int CTL_ATTQ = 8512;
constexpr int CTL_MOEQ = 8640;
constexpr int CTL_RWAQ = 8960;
constexpr int CTL_SSDQ = 9024;

extern __shared__ __attribute__((aligned(16))) char g_smem[];
constexpr int HALF_LDS = 66048;
constexpr int HS_OFF = 2 * HALF_LDS;
constexpr int XST_OFF = HS_OFF + 128;
constexpr int LDS_TOTAL = XST_OFF + 64;
DEVINL int my_tid() { int t = threadIdx.x & 255; asm volatile("" : "+v"(t)); return t; }
DEVINL void hsync() {
  asm volatile("s_waitcnt lgkmcnt(0)" ::: "memory");
  if ((threadIdx.x & 63) == 0) {
    unsigned* c = (unsigned*)(g_smem + HS_OFF + (threadIdx.x >> 8) * 64);
    const unsigned v = __hip_atomic_fetch_add(c, 1u, __ATOMIC_RELAXED, __HIP_MEMORY_SCOPE_WORKGROUP);
    if ((v & 3u) != 3u) {
      const unsigned target = (v & ~3u) + 4u;
      while ((int)(__hip_atomic_load(c, __ATOMIC_RELAXED, __HIP_MEMORY_SCOPE_WORKGROUP) - target) < 0) {}
    }
  }
  asm volatile("" ::: "memory");
}
DEVINL float bf2f(bf16_t h) { return __uint_as_float(((unsigned)h) << 16); }
typedef float f32x2_t __attribute__((ext_vector_type(2)));
typedef __bf16 hwbf16x2_t __attribute__((ext_vector_type(2)));
DEVINL unsigned pk2(float a, float b) { const f32x2_t v = {a, b}; return __builtin_bit_cast(unsigned, __builtin_convertvector(v, hwbf16x2_t)); }
DEVINL bf16_t f2bf(float f) { return __builtin_bit_cast(bf16_t, (__bf16)f); }
DEVINL float lo2f(unsigned u) { return __uint_as_float(u << 16); }
DEVINL float hi2f(unsigned u) { return __uint_as_float(u & 0xffff0000u); }
template <int CTRL> DEVINL float dpp_rot(float x) { return __int_as_float(__builtin_amdgcn_update_dpp(0, __float_as_int(x), CTRL, 0xF, 0xF, true)); }
DEVINL float wave_sum(float v) {
  v += dpp_rot<0x128>(v); v += dpp_rot<0x124>(v); v += dpp_rot<0x122>(v); v += dpp_rot<0x121>(v);
  v += __shfl_xor(v, 16); v += __shfl_xor(v, 32);
  return v;
}
DEVINL float sigmoid_(float x) { return __builtin_amdgcn_rcpf(1.f + __expf(-x)); }
DEVINL float softplus_(float x) { return fmaxf(x, 0.f) + __logf(1.f + __expf(-fabsf(x))); }
DEVINL float silu_(float x) { return x * __builtin_amdgcn_rcpf(1.f + __expf(-x)); }
DEVINL float tanh_(float x) { const float e = __expf(-2.f * fabsf(x)); const float t = (1.f - e) * __builtin_amdgcn_rcpf(1.f + e); return copysignf(t, x); }
DEVINL void st4bf(bf16_t* p, float a, float b, float c, float d) { u32x2 v; v.x = pk2(a, b); v.y = pk2(c, d); *(u32x2*)p = v; }
DEVINL void ld8bf(const bf16_t* p, float* o) {
  u32x4 v = *(const u32x4*)p;
  o[0] = lo2f(v.x); o[1] = hi2f(v.x); o[2] = lo2f(v.y); o[3] = hi2f(v.y);
  o[4] = lo2f(v.z); o[5] = hi2f(v.z); o[6] = lo2f(v.w); o[7] = hi2f(v.w);
}
DEVINL void ld4bf(const bf16_t* p, float* o) {
  u32x2 v = *(const u32x2*)p;
  o[0] = lo2f(v.x); o[1] = hi2f(v.x); o[2] = lo2f(v.y); o[3] = hi2f(v.y);
}

#define GLDS16(g, l) __builtin_amdgcn_global_load_lds((const unsigned*)(g), (unsigned*)(l), 16, 0, 0)
DEVINL void gemm_core(f32x4 (&acc)[4][4], const bf16_t* const (&a)[4], long as, const bf16_t* const (&b)[4], long bs, int nk, char* lds) {
  const int tid = my_tid(), lane = tid & 63, wid = tid >> 6, wr = wid >> 1, wc = wid & 1, fr = lane & 15, fq = lane >> 4;
  const int sw = fr >> 1;
#pragma unroll
  for (int i = 0; i < 4; ++i) {
    GLDS16(a[i], lds + (tid + 256 * i) * 16);
    GLDS16(b[i], lds + 16384 + (tid + 256 * i) * 16);
  }
  for (int kt = 0; kt < nk; ++kt) {
    char* sA = lds + (kt & 1) * 32768;
    char* sB = sA + 16384;
    asm volatile("s_waitcnt vmcnt(0)" ::: "memory"); hsync();
    if (kt + 1 < nk) {
      char* nA = lds + ((kt + 1) & 1) * 32768;
#pragma unroll
      for (int i = 0; i < 4; ++i) {
        GLDS16(a[i] + (kt + 1) * as, nA + (tid + 256 * i) * 16);
        GLDS16(b[i] + (kt + 1) * bs, nA + 16384 + (tid + 256 * i) * 16);
      }
    }
#pragma unroll
    for (int kk = 0; kk < 2; ++kk) {
      bf16x8 af[4], bfr[4];
      const int so = ((kk * 4 + fq) ^ sw) * 16;
#pragma unroll
      for (int m = 0; m < 4; ++m) af[m] = *(const bf16x8*)(sA + (wr * 64 + m * 16 + fr) * 128 + so);
#pragma unroll
      for (int n = 0; n < 4; ++n) bfr[n] = *(const bf16x8*)(sB + (wc * 64 + n * 16 + fr) * 128 + so);
#pragma unroll
      for (int m = 0; m < 4; ++m)
#pragma unroll
        for (int n = 0; n < 4; ++n) acc[m][n] = __builtin_amdgcn_mfma_f32_16x16x32_bf16(bfr[n], af[m], acc[m][n], 0, 0, 0);
    }
  }
  hsync();
}
DEVINL void acc_zero(f32x4 (&acc)[4][4]) {
#pragma unroll
  for (int m = 0; m < 4; ++m)
#pragma unroll
    for (int n = 0; n < 4; ++n) acc[m][n] = (f32x4){0.f, 0.f, 0.f, 0.f};
}
#define ROWS4(name, base, row0, ld) const bf16_t* const name[4] = {(base) + (size_t)((row0) + lr) * (ld) + lc, (base) + (size_t)((row0) + lr + 32) * (ld) + lc, \
  (base) + (size_t)((row0) + lr + 64) * (ld) + lc, (base) + (size_t)((row0) + lr + 96) * (ld) + lc}
#define TILE_IDS const int tid = my_tid(), lane = tid & 63, wid = tid >> 6, wr = wid >> 1, wc = wid & 1, fr = lane & 15, fq = lane >> 4; \
  const int lr = tid >> 3, lc = ((tid & 7) ^ ((tid >> 4) & 7)) * 8; (void)lane; (void)wr; (void)wc; (void)fr; (void)fq; (void)lr; (void)lc;

DEVINL int conv_row(int n, int mode) {
  if (mode == 0) return n;
  if (mode == 1) { int j = n & 511; return (j >> 4) * 32 + (n >= 512 ? 16 : 0) + (j & 15); }
  return (n >> 4) * 32 + (mode == 3 ? 16 : 0) + (n & 15);
}
DEVINL void conv_tile(const float* src, int K, int N, int tile, bf16_t* dst, int mode, float* st  ) {
  const int tid = my_tid();
  const int ntn = (N + 63) >> 6;
  const int k0 = (tile / ntn) * 64, n0 = (tile % ntn) * 64;
  float v[16];
#pragma unroll
  for (int i = 0; i < 16; ++i) {
    int k = i * 4 + (tid >> 6), n = n0 + (tid & 63);
    v[i] = (n < N) ? __builtin_nontemporal_load(src + (size_t)(k0 + k) * N + n) : 0.f;
  }
#pragma unroll
  for (int i = 0; i < 16; ++i) st[(i * 4 + (tid >> 6)) * 65 + (tid & 63)] = v[i];
  hsync();
#pragma unroll
  for (int i = 0; i < 2; ++i) {
    int idx = tid + 256 * i, nl = idx >> 3, kc = idx & 7, n = n0 + nl;
    if (n < N) {
      const float* s = st + (kc * 8) * 65 + nl;
      u32x4 o;
      o.x = pk2(s[0], s[65]); o.y = pk2(s[130], s[195]); o.z = pk2(s[260], s[325]); o.w = pk2(s[390], s[455]);
      *(u32x4*)(dst + (size_t)conv_row(n, mode) * K + k0 + kc * 8) = o;
    }
  }
  hsync();
}

constexpr int PREP_NCONV = 512 + 128 + 256 + 848 + 256 + 8 + 8 + 16;
constexpr int PREP_ADA0 = PREP_NCONV, PREP_NADA = 192;
constexpr int PREP_S50 = PREP_ADA0 + PREP_NADA, PREP_NS5 = 32 * 65;
constexpr int PREP_RW0 = PREP_S50 + PREP_NS5, PREP_NRW = 96;
constexpr int PREP_PAD0 = PREP_RW0 + PREP_NRW, PREP_NPAD = 31;
constexpr int PREP_ITEMS = PREP_PAD0 + PREP_NPAD;

DEVINL void prep_ada(const Params& p, int item, char* smem) {
  float* cond = (float*)smem;
  float* part = cond + 8192;
  const int tid = my_tid(), lane = tid & 63, wid = tid >> 6;
  const int l = item / 96, j0 = (item % 96) * 64;
  for (int i = tid; i < 8192; i += 256) cond[i] = silu_(p.in[I_C][i]);
  hsync();
  const float* W = p.in[I_ADA_W] + (size_t)l * 1024 * 6144 + j0 + lane;
  float acc[8];
#pragma unroll
  for (int b = 0; b < 8; ++b) acc[b] = 0.f;
#pragma unroll 32
  for (int k = wid * 256; k < wid * 256 + 256; ++k) {
    float w = W[(size_t)k * 6144];
#pragma unroll
    for (int b = 0; b < 8; ++b) acc[b] += cond[b * 1024 + k] * w;
  }
#pragma unroll
  for (int b = 0; b < 8; ++b) part[(wid * 8 + b) * 64 + lane] = acc[b];
  hsync();
  float* mod = (float*)(p.ws + OFF_MOD);
  for (int i = tid; i < 512; i += 256) {
    int b = i >> 6, jj = i & 63;
    float s = part[(0 * 8 + b) * 64 + jj] + part[(1 * 8 + b) * 64 + jj] + part[(2 * 8 + b) * 64 + jj] + part[(3 * 8 + b) * 64 + jj];
    mod[((size_t)l * 8 + b) * 6144 + j0 + jj] = s + p.in[I_ADA_B][l * 6144 + j0 + jj];
  }
  hsync();
}

DEVINL void prep_s5(const Params& p, int item, char* smem) {
  float* pw_re = (float*)smem;
  float* pw_im = pw_re + 64;
  float* cf_re = pw_im + 64;
  float* cf_im = cf_re + 64;
  float* bb_re = cf_im + 64;
  float* bb_im = bb_re + 1024;
  const int tid = my_tid();
  const int g = item / 65, j = item % 65;
  if (tid < 64) {
    const int n = tid;
    const float are = fminf(p.in[I_S5_ARE][g * 64 + n], -1e-4f), aim = p.in[I_S5_AIM][g * 64 + n];
    const float dt = expf(p.in[I_S5_LOGDT][g]);
    float sn, cs;
    sincosf(dt * aim, &sn, &cs);
    const float mag = expf(dt * are), ar = mag * cs, ai = mag * sn;
    const float den = are * are + aim * aim, nr = ar - 1.f, ni = ai;
    cf_re[n] = (nr * are + ni * aim) / den;
    cf_im[n] = (ni * are - nr * aim) / den;
    const float mj = expf((float)j * dt * are);
    sincosf((float)j * dt * aim, &sn, &cs);
    pw_re[n] = mj * cs;
    pw_im[n] = mj * sn;
  }
  hsync();
  for (int i = tid; i < 1024; i += 256) {
    int n = i >> 4;
    float br = p.in[I_S5_BRE][g * 1024 + i], bi = p.in[I_S5_BIM][g * 1024 + i];
    bb_re[i] = cf_re[n] * br - cf_im[n] * bi;
    bb_im[i] = cf_re[n] * bi + cf_im[n] * br;
  }
  hsync();
  bf16_t* Kx = (bf16_t*)(p.ws + OFF_S5K);
  bf16_t* F = (bf16_t*)(p.ws + OFF_S5F);
  bf16_t* E = (bf16_t*)(p.ws + OFF_S5E);
  const float* cre = p.in[I_S5_CRE] + g * 1024;
  const float* cim = p.in[I_S5_CIM] + g * 1024;
  if (j < 8) Kx[((size_t)g * 72 + j) * 256 + tid] = 0;
  if (j < 64) {
    const int pp = tid >> 4, q = tid & 15;
    float s = 0.f;
    for (int n = 0; n < 64; ++n) {
      float xr = pw_re[n] * bb_re[n * 16 + q] - pw_im[n] * bb_im[n * 16 + q];
      float xi = pw_re[n] * bb_im[n * 16 + q] + pw_im[n] * bb_re[n * 16 + q];
      s += cre[pp * 64 + n] * xr - cim[pp * 64 + n] * xi;
    }
    Kx[((size_t)g * 72 + j + 8) * 256 + tid] = f2bf(s);
    const int sidx = 63 - j;
    for (int i = tid; i < 1024; i += 256) {
      int n = i >> 4, qq = i & 15;
      float xr = pw_re[n] * bb_re[i] - pw_im[n] * bb_im[i];
      float xi = pw_re[n] * bb_im[i] + pw_im[n] * bb_re[i];
      F[((size_t)g * 128 + n) * 1024 + sidx * 16 + qq] = f2bf(xr);
      F[((size_t)g * 128 + 64 + n) * 1024 + sidx * 16 + qq] = f2bf(xi);
    }
  }
  if (j >= 1) {
    const int t = j - 1;
    for (int i = tid; i < 1024; i += 256) {
      int pp = i >> 6, n = i & 63;
      float cr = cre[pp * 64 + n], ci = cim[pp * 64 + n];
      E[((size_t)g * 1024 + t * 16 + pp) * 128 + n] = f2bf(cr * pw_re[n] - ci * pw_im[n]);
      E[((size_t)g * 1024 + t * 16 + pp) * 128 + 64 + n] = f2bf(-(cr * pw_im[n] + ci * pw_re[n]));
    }
  }
  if (j == 64 && tid < 64) {
    float* P64 = (float*)(p.ws + OFF_S5P);
    P64[(g * 64 + tid) * 2] = pw_re[tid];
    P64[(g * 64 + tid) * 2 + 1] = pw_im[tid];
  }
  hsync();
}

DEVINL void prep_conv_item(const Params& p, int r, float* st) {
  if (r < 512) { conv_tile(p.in[I_EVEN_WIN], 1024, 2048, r, (bf16_t*)(p.ws + OFF_WIN0), 0, st); return; } r -= 512;
  if (r < 128) { conv_tile(p.in[I_S5_WGLU], 512, 1024, r, (bf16_t*)(p.ws + OFF_WGLU), 1, st); return; } r -= 128;
  if (r < 256) { conv_tile(p.in[I_EVEN_WOUT], 1024, 1024, r, (bf16_t*)(p.ws + OFF_WOUT0), 0, st); return; } r -= 256;
  if (r < 848) { conv_tile(p.in[I_ODD_WIN], 1024, 3336, r, (bf16_t*)(p.ws + OFF_WIN1), 0, st); return; } r -= 848;
  if (r < 256) { conv_tile(p.in[I_ODD_WOUT], 1024, 1024, r, (bf16_t*)(p.ws + OFF_WOUT1), 0, st); return; } r -= 256;
  if (r < 8) { conv_tile(p.in[I_RW_W2], 64, 512, r, (bf16_t*)(p.ws + OFF_W2T), 0, st); return; } r -= 8;
  if (r < 8) { conv_tile(p.in[I_RW_A2], 64, 512, r, (bf16_t*)(p.ws + OFF_A2T), 0, st); return; } r -= 8;
  conv_tile(p.in[I_RW_G2], 128, 512, r, (bf16_t*)(p.ws + OFF_G2T), 0, st);
}
constexpr int PREP_NCONV0 = 896;
DEVINL void phase_prep(const Params& p, int bid, int nb, char* smem) {
  for (int item = bid; item < PREP_ITEMS; item += nb) {
    if (item < PREP_NCONV) {
      if (item < PREP_NCONV0) prep_conv_item(p, item, (float*)smem);
    } else if (item < PREP_S50) {
      prep_ada(p, item - PREP_ADA0, smem);
    } else if (item < PREP_RW0) {
      prep_s5(p, item - PREP_S50, smem);
    } else if (item < PREP_PAD0) {
      const int r = item - PREP_RW0, l = r / 48, o = r % 48;
      bf16_t* dst = (bf16_t*)(p.ws + OFF_RWT) + (size_t)l * 98304;
      for (int k = my_tid(); k < 1024; k += 256) {
        const float w = (o >= 36) ? 0.f : (o < 4) ? p.in[I_MOE_WGRP][((size_t)l * 1024 + k) * 4 + o] : p.in[I_MOE_WEXP][((size_t)l * 1024 + k) * 32 + (o - 4)];
        const bf16_t hi = f2bf(w), lo = f2bf(w - bf2f(hi));
        const size_t off = ((size_t)(((k >> 5) * 3 + (o >> 4)) * 2) * 64 + ((k >> 3) & 3) * 16 + (o & 15)) * 8 + (k & 7);
        dst[off] = hi; dst[off + 512] = lo;
      }
    } else {
      const int r = item - PREP_PAD0;
      u32x4* dst = (u32x4*)((bf16_t*)(p.ws + OFF_WIN1) + (size_t)(3336 + r * 8) * 1024);
      for (int i = my_tid(); i < 1024; i += 256) dst[i] = (u32x4){0u, 0u, 0u, 0u};
    }
  }
}
DEVINL void phase_prep_l1(const Params& p, int bid, int nb, char* smem) {
  for (int item = PREP_NCONV0 + bid; item < PREP_NCONV; item += nb) prep_conv_item(p, item, (float*)smem);
}

DEVINL void phase_moe_convert(const Params& p, int bid, int nb, int L, char* smem, int item0 = 0, int item1 = 12288) {
  float* st = (float*)smem;
  for (int item = item0 + bid; item < item1; item += nb) {
    const int e = item / 384, r = item % 384;
    const size_t eoff = ((size_t)L * 32 + e) * 524288;
    if (r < 128) conv_tile(p.in[I_MOE_WGATE] + eoff, 1024, 512, r, (bf16_t*)(p.ws + OFF_WGU) + (size_t)e * 1048576, 2, st);
    else if (r < 256) conv_tile(p.in[I_MOE_WUP] + eoff, 1024, 512, r - 128, (bf16_t*)(p.ws + OFF_WGU) + (size_t)e * 1048576, 3, st);
    else conv_tile(p.in[I_MOE_WDOWN] + eoff, 512, 1024, r - 256, (bf16_t*)(p.ws + OFF_WD) + (size_t)e * 524288, 0, st);
  }
}

DEVINL void moe_prefix(const Params& p, int L, int* pad_start  ) {
  const int* ctl = (const int*)(p.ws + OFF_CTL);
  if (my_tid() == 0) {
    int s = 0;
    for (int e = 0; e < 32; ++e) { pad_start[e] = s; s += ((ctl[CTL_COUNT + (L * 32 + e) * 32] + 255) >> 8) << 8; }
    pad_start[32] = s;
  }
  hsync();
}
DEVINL void route_flush(const Params& p, int L, const int* pend, int n, int lane) {
  __builtin_amdgcn_wave_barrier();
  if (lane < n) {
    int* ctl = (int*)(p.ws + OFF_CTL);
    int* ri = (int*)(p.ws + OFF_ROUTE);
    int* list = (int*)(p.ws + OFF_LIST);
    const int tok = pend[lane * 4], e0 = pend[lane * 4 + 1], e1 = pend[lane * 4 + 2];
    const int p0 = atomicAdd(&ctl[CTL_COUNT + (L * 32 + e0) * 32], 1);
    const int p1 = atomicAdd(&ctl[CTL_COUNT + (L * 32 + e1) * 32], 1);
    ri[0 * T + tok] = e0; ri[1 * T + tok] = e1; ri[4 * T + tok] = p0; ri[5 * T + tok] = p1;
    list[(size_t)e0 * T + p0] = tok; list[(size_t)e1 * T + p1] = tok;
  }
  __builtin_amdgcn_wave_barrier();
}
template <int CTRL> DEVINL float dpp_mov_(float x) { return __int_as_float(__builtin_amdgcn_update_dpp(0, __float_as_int(x), CTRL, 0xF, 0xF, true)); }
DEVINL float wave_sum_fast(float v) {
  v += dpp_mov_<0x128>(v); v += dpp_mov_<0x124>(v); v += dpp_mov_<0x122>(v); v += dpp_mov_<0x121>(v);
  v += __shfl_xor(v, 16); v += __shfl_xor(v, 32);
  return v;
}
DEVINL void phase_norm_router(const Params& p, int bid, int nb, int L, char* smem) {
  const int tid = my_tid(), lane = tid & 63, wid = tid >> 6, fr = lane & 15, fq = lane >> 4;
  float* wsc = (float*)smem;
  float* shf = wsc + 1024;
  float* slog = (float*)(smem + 8192) + wid * (16 * 49);
  int* lcnt = (int*)(smem + 8192 + 12544);
  int* lbase = lcnt + 32;
  const float* mod = (const float*)(p.ws + OFF_MOD);
  bf16_t* H = (bf16_t*)(p.ws + OFF_H);
  const float* nw = p.in[I_NORM_FFN] + L * 1024;
  const bf16_t* Wf = (const bf16_t*)(p.ws + OFF_RWT) + (size_t)L * 98304 + lane * 8;
  const bf16_t* xres = (L == 0) ? (const bf16_t*)p.out : (const bf16_t*)(p.ws + OFF_XR1);
  for (int tile = bid; tile < T / 64; tile += nb) {
    const int row0 = tile * 64 + wid * 16, b = row0 >> 12;
    const float* shift = mod + ((size_t)L * 8 + b) * 6144 + 3 * 1024;
    const float* scale = shift + 1024;
    hsync();
    {
      const int c = tid * 4;
      const f32x4 w = *(const f32x4*)(nw + c), sc = *(const f32x4*)(scale + c), sh = *(const f32x4*)(shift + c);
      *(f32x4*)(wsc + c) = (f32x4){w.x * (1.f + sc.x), w.y * (1.f + sc.y), w.z * (1.f + sc.z), w.w * (1.f + sc.w)};
      *(f32x4*)(shf + c) = sh;
      if (tid < 32) lcnt[tid] = 0;
    }
    const bf16_t* xrow = xres + (size_t)(row0 + fr) * 1024 + 8 * fq;
    float ss = 0.f;
#pragma unroll 16
    for (int s2 = 0; s2 < 32; ++s2) {
      const u32x4 x = *(const u32x4*)(xrow + 32 * s2);
      const float a0 = lo2f(x.x), a1 = hi2f(x.x), a2 = lo2f(x.y), a3 = hi2f(x.y), a4 = lo2f(x.z), a5 = hi2f(x.z), a6 = lo2f(x.w), a7 = hi2f(x.w);
      ss += a0 * a0 + a1 * a1 + a2 * a2 + a3 * a3 + a4 * a4 + a5 * a5 + a6 * a6 + a7 * a7;
    }
    ss += __shfl_xor(ss, 16); ss += __shfl_xor(ss, 32);
    const float rstd = rsqrtf(ss * (1.f / 1024.f) + 1e-6f);
    hsync();
    f32x4 acc[3];
#pragma unroll
    for (int n = 0; n < 3; ++n) acc[n] = (f32x4){0.f, 0.f, 0.f, 0.f};
    bf16_t* hrow = H + (size_t)(row0 + fr) * 1024 + 8 * fq;
#pragma unroll 4
    for (int s2 = 0; s2 < 32; ++s2) {
      const int col0 = 32 * s2 + 8 * fq;
      const u32x4 x = *(const u32x4*)(xrow + 32 * s2);
      bf16x8 wh[3], wl[3];
#pragma unroll
      for (int n = 0; n < 3; ++n) { wh[n] = *(const bf16x8*)(Wf + (size_t)((s2 * 3 + n) * 2) * 512); wl[n] = *(const bf16x8*)(Wf + (size_t)((s2 * 3 + n) * 2 + 1) * 512); }
      const f32x4 w0 = *(const f32x4*)(wsc + col0), w1 = *(const f32x4*)(wsc + col0 + 4), s0 = *(const f32x4*)(shf + col0), s1 = *(const f32x4*)(shf + col0 + 4);
      float h[8];
      h[0] = lo2f(x.x) * rstd * w0.x + s0.x; h[1] = hi2f(x.x) * rstd * w0.y + s0.y; h[2] = lo2f(x.y) * rstd * w0.z + s0.z; h[3] = hi2f(x.y) * rstd * w0.w + s0.w;
      h[4] = lo2f(x.z) * rstd * w1.x + s1.x; h[5] = hi2f(x.z) * rstd * w1.y + s1.y; h[6] = lo2f(x.w) * rstd * w1.z + s1.z; h[7] = hi2f(x.w) * rstd * w1.w + s1.w;
      u32x4 ph, pl;
      {
        bf16_t q[8];
#pragma unroll
        for (int j = 0; j < 8; ++j) q[j] = f2bf(h[j]);
        ph.x = (unsigned)q[0] | ((unsigned)q[1] << 16); ph.y = (unsigned)q[2] | ((unsigned)q[3] << 16);
        ph.z = (unsigned)q[4] | ((unsigned)q[5] << 16); ph.w = (unsigned)q[6] | ((unsigned)q[7] << 16);
        pl.x = pk2(h[0] - bf2f(q[0]), h[1] - bf2f(q[1])); pl.y = pk2(h[2] - bf2f(q[2]), h[3] - bf2f(q[3]));
        pl.z = pk2(h[4] - bf2f(q[4]), h[5] - bf2f(q[5])); pl.w = pk2(h[6] - bf2f(q[6]), h[7] - bf2f(q[7]));
      }
      *(u32x4*)(hrow + 32 * s2) = ph;
      const bf16x8 xh = __builtin_bit_cast(bf16x8, ph), xl = __builtin_bit_cast(bf16x8, pl);
#pragma unroll
      for (int n = 0; n < 3; ++n) {
        acc[n] = __builtin_amdgcn_mfma_f32_16x16x32_bf16(wh[n], xh, acc[n], 0, 0, 0);
        acc[n] = __builtin_amdgcn_mfma_f32_16x16x32_bf16(wl[n], xh, acc[n], 0, 0, 0);
        acc[n] = __builtin_amdgcn_mfma_f32_16x16x32_bf16(wh[n], xl, acc[n], 0, 0, 0);
      }
    }
#pragma unroll
    for (int n = 0; n < 3; ++n) {
      slog[fr * 49 + 16 * n + 4 * fq + 0] = acc[n].x; slog[fr * 49 + 16 * n + 4 * fq + 1] = acc[n].y;
      slog[fr * 49 + 16 * n + 4 * fq + 2] = acc[n].z; slog[fr * 49 + 16 * n + 4 * fq + 3] = acc[n].w;
    }
    __builtin_amdgcn_wave_barrier();
    int e0 = 0, e1 = 0, r0 = 0, r1 = 0;
    if (lane < 16) {
      const float* lg = slog + lane * 49;
      const int row = row0 + lane;
      float gl[4];
#pragma unroll
      for (int i = 0; i < 4; ++i) gl[i] = lg[i] + p.in[I_MOE_BGRP][L * 4 + i];
      int gi = 0; float gm = gl[0];
#pragma unroll
      for (int i = 1; i < 4; ++i) if (gl[i] > gm) { gm = gl[i]; gi = i; }
      float den = 0.f;
#pragma unroll
      for (int i = 0; i < 4; ++i) den += expf(gl[i] - gm);
      const float grp_p = 1.f / den;
      float el[8];
#pragma unroll
      for (int i = 0; i < 8; ++i) el[i] = lg[4 + gi * 8 + i] + p.in[I_MOE_BEXP][L * 32 + gi * 8 + i];
      int i0 = 0; float m0 = el[0];
#pragma unroll
      for (int i = 1; i < 8; ++i) if (el[i] > m0) { m0 = el[i]; i0 = i; }
      int i1 = -1; float m1 = -3.0e38f;
#pragma unroll
      for (int i = 0; i < 8; ++i) if (i != i0 && el[i] > m1) { m1 = el[i]; i1 = i; }
      const float p0 = 1.f / (1.f + expf(m1 - m0));
      const float p1 = 1.f - p0;
      float* rf = (float*)(p.ws + OFF_ROUTE);
      rf[2 * T + row] = grp_p * p0; rf[3 * T + row] = grp_p * p1;
      e0 = gi * 8 + i0; e1 = gi * 8 + i1;
      r0 = atomicAdd(&lcnt[e0], 1); r1 = atomicAdd(&lcnt[e1], 1);
    }
    hsync();
    if (tid < 32) { const int c = lcnt[tid]; lbase[tid] = (c > 0) ? atomicAdd((int*)(p.ws + OFF_CTL) + CTL_COUNT + (L * 32 + tid) * 32, c) : 0; }
    hsync();
    if (lane < 16) {
      const int tok = row0 + lane, q0 = lbase[e0] + r0, q1 = lbase[e1] + r1;
      int* ri = (int*)(p.ws + OFF_ROUTE);
      int* list = (int*)(p.ws + OFF_LIST);
      ri[0 * T + tok] = e0; ri[1 * T + tok] = e1; ri[4 * T + tok] = q0; ri[5 * T + tok] = q1;
      list[(size_t)e0 * T + q0] = tok; list[(size_t)e1 * T + q1] = tok;
    }
  }
}
DEVINL void phase_norm(const Params& p, int bid, int nb, int mode, int L, char* smem) {
  const int tid = my_tid(), lane = tid & 63, wid = tid >> 6;
  int* pad_start = (int*)smem;
  if (mode >= 2) moe_prefix(p, (mode == 2) ? L - 1 : L, pad_start);
  const float* xin = p.in[I_X];
  const bf16_t* xres = (mode == 3) ? (const bf16_t*)(p.ws + OFF_XR1) : (const bf16_t*)p.out;
  const float* mod = (const float*)(p.ws + OFF_MOD);
  bf16_t* H = (bf16_t*)(p.ws + OFF_H);
  const int* rt_i = (const int*)(p.ws + OFF_ROUTE);
  const float* rt_f = (const float*)(p.ws + OFF_ROUTE);
  const bf16_t* Y = (const bf16_t*)(p.ws + OFF_YEXP);
  const int Lc = (mode == 2) ? L - 1 : L;
  const float* nw = (mode == 3) ? p.in[I_FINAL_W] : p.in[I_NORM_MIX] + L * 1024;
  const int nwaves = nb * 4;
  for (int row0 = (bid * 4 + wid) * 2; row0 < T; row0 += nwaves * 2) {
    const int b = row0 >> 12;
    f32x4 v[2][4];
    if (mode == 0) {
#pragma unroll
      for (int r = 0; r < 2; ++r)
#pragma unroll
        for (int j = 0; j < 4; ++j) v[r][j] = *(const f32x4*)(xin + (size_t)(row0 + r) * 1024 + j * 256 + lane * 4);
    } else {
      u32x2 xr[2][4];
#pragma unroll
      for (int r = 0; r < 2; ++r)
#pragma unroll
        for (int j = 0; j < 4; ++j) xr[r][j] = *(const u32x2*)(xres + (size_t)(row0 + r) * 1024 + j * 256 + lane * 4);
      if (mode >= 2) {
        int s0[2], s1[2]; float g0[2], g1[2];
#pragma unroll
        for (int r = 0; r < 2; ++r) {
          const int row = row0 + r;
          s0[r] = pad_start[rt_i[0 * T + row]] + rt_i[4 * T + row]; s1[r] = pad_start[rt_i[1 * T + row]] + rt_i[5 * T + row];
          g0[r] = rt_f[2 * T + row]; g1[r] = rt_f[3 * T + row];
        }
        u32x2 ya[2][4], yb[2][4];
#pragma unroll
        for (int r = 0; r < 2; ++r)
#pragma unroll
          for (int j = 0; j < 4; ++j) {
            ya[r][j] = *(const u32x2*)(Y + (size_t)s0[r] * 1024 + j * 256 + lane * 4);
            yb[r][j] = *(const u32x2*)(Y + (size_t)s1[r] * 1024 + j * 256 + lane * 4);
          }
        const float* gate2 = mod + ((size_t)Lc * 8 + b) * 6144 + 5 * 1024;
#pragma unroll
        for (int j = 0; j < 4; ++j) {
          const f32x4 gt = *(const f32x4*)(gate2 + j * 256 + lane * 4);
#pragma unroll
          for (int r = 0; r < 2; ++r) {
            v[r][j].x = lo2f(xr[r][j].x) + gt.x * (g0[r] * lo2f(ya[r][j].x) + g1[r] * lo2f(yb[r][j].x));
            v[r][j].y = hi2f(xr[r][j].x) + gt.y * (g0[r] * hi2f(ya[r][j].x) + g1[r] * hi2f(yb[r][j].x));
            v[r][j].z = lo2f(xr[r][j].y) + gt.z * (g0[r] * lo2f(ya[r][j].y) + g1[r] * lo2f(yb[r][j].y));
            v[r][j].w = hi2f(xr[r][j].y) + gt.w * (g0[r] * hi2f(ya[r][j].y) + g1[r] * hi2f(yb[r][j].y));
          }
        }
        if (mode == 2) {
#pragma unroll
          for (int r = 0; r < 2; ++r)
#pragma unroll
            for (int j = 0; j < 4; ++j) st4bf((bf16_t*)p.out + (size_t)(row0 + r) * 1024 + j * 256 + lane * 4, v[r][j].x, v[r][j].y, v[r][j].z, v[r][j].w);
        }
      } else {
#pragma unroll
        for (int r = 0; r < 2; ++r)
#pragma unroll
          for (int j = 0; j < 4; ++j) v[r][j] = (f32x4){lo2f(xr[r][j].x), hi2f(xr[r][j].x), lo2f(xr[r][j].y), hi2f(xr[r][j].y)};
      }
    }
    float rstd[2];
#pragma unroll
    for (int r = 0; r < 2; ++r) {
      float ss = 0.f;
#pragma unroll
      for (int j = 0; j < 4; ++j) ss += v[r][j].x * v[r][j].x + v[r][j].y * v[r][j].y + v[r][j].z * v[r][j].z + v[r][j].w * v[r][j].w;
      ss = wave_sum(ss);
      rstd[r] = rsqrtf(ss * (1.f / 1024.f) + 1e-6f);
    }
    if (mode == 3) {
#pragma unroll
      for (int j = 0; j < 4; ++j) {
        const int c = j * 256 + lane * 4;
        const f32x4 w = *(const f32x4*)(nw + c);
#pragma unroll
        for (int r = 0; r < 2; ++r) {
          f32x4 o; o.x = v[r][j].x * rstd[r] * w.x; o.y = v[r][j].y * rstd[r] * w.y; o.z = v[r][j].z * rstd[r] * w.z; o.w = v[r][j].w * rstd[r] * w.w;
          *(f32x4*)(p.out + (size_t)(row0 + r) * 1024 + c) = o;
        }
      }
      continue;
    }
    const float* shift = mod + ((size_t)L * 8 + b) * 6144;
    const float* scale = shift + 1024;
#pragma unroll
    for (int j = 0; j < 4; ++j) {
      const int c = j * 256 + lane * 4;
      const f32x4 w = *(const f32x4*)(nw + c), sc = *(const f32x4*)(scale + c), sh = *(const f32x4*)(shift + c);
#pragma unroll
      for (int r = 0; r < 2; ++r)
        st4bf(H + (size_t)(row0 + r) * 1024 + c, v[r][j].x * rstd[r] * w.x * (1.f + sc.x) + sh.x, v[r][j].y * rstd[r] * w.y * (1.f + sc.y) + sh.y,
              v[r][j].z * rstd[r] * w.z * (1.f + sc.z) + sh.z, v[r][j].w * rstd[r] * w.w * (1.f + sc.w) + sh.w);
    }
  }
}
DEVINL void phase_inproj0(const Params& p, int bid, int nb, char* smem) {
  TILE_IDS
  const bf16_t* A = (const bf16_t*)(p.ws + OFF_H);
  const bf16_t* B = (const bf16_t*)(p.ws + OFF_WIN0);
  bf16_t* C = (bf16_t*)(p.ws + OFF_PROJ0);
  for (int tile = bid; tile < 256 * 16; tile += nb) {
    const int xj = tile >> 3, mt = (xj >> 4) * 8 + (tile & 7), nt = xj & 15;
    ROWS4(ap, A, mt * 128, 1024);
    ROWS4(bp, B, nt * 128, 1024);
    f32x4 acc[4][4]; acc_zero(acc);
    gemm_core(acc, ap, 64, bp, 64, 16, smem);
#pragma unroll
    for (int m = 0; m < 4; ++m)
#pragma unroll
      for (int n = 0; n < 4; ++n) {
        const int row = mt * 128 + wr * 64 + m * 16 + fr, col = nt * 128 + wc * 64 + n * 16 + fq * 4;
        st4bf(C + (size_t)row * 2048 + col, acc[m][n].x, acc[m][n].y, acc[m][n].z, acc[m][n].w);
      }
  }
}
DEVINL void phase_inproj1(const Params& p, int bid, int nb, char* smem) {
  TILE_IDS
  const bf16_t* A = (const bf16_t*)(p.ws + OFF_H);
  const bf16_t* B = (const bf16_t*)(p.ws + OFF_WIN1);
  bf16_t* CR = (bf16_t*)(p.ws + OFF_PROJR);
  bf16_t* CM = (bf16_t*)(p.ws + OFF_PROJM);
  float* DT = (float*)(p.ws + OFF_DTRAW);
  for (int tile = bid; tile < 256 * 27; tile += nb) {
    const int xj = tile >> 3, mt = (xj / 27) * 8 + (tile & 7), nt = xj % 27;
    ROWS4(ap, A, mt * 128, 1024);
    ROWS4(bp, B, nt * 128, 1024);
    f32x4 acc[4][4]; acc_zero(acc);
    gemm_core(acc, ap, 64, bp, 64, 16, smem);
#pragma unroll
    for (int m = 0; m < 4; ++m)
#pragma unroll
      for (int n = 0; n < 4; ++n) {
        const int row = mt * 128 + wr * 64 + m * 16 + fr, col = nt * 128 + wc * 64 + n * 16 + fq * 4;
        if (col < 1792) st4bf(CR + (size_t)row * 1792 + col, acc[m][n].x, acc[m][n].y, acc[m][n].z, acc[m][n].w);
        else {
          st4bf(CM + (size_t)row * 1664 + (col - 1792), acc[m][n].x, acc[m][n].y, acc[m][n].z, acc[m][n].w);
          if (col >= 3328 && col < 3336) *(f32x4*)(DT + (size_t)row * 8 + (col - 3328)) = acc[m][n];
        }
      }
  }
}
DEVINL void phase_glu(const Params& p, int bid, int nb, char* smem) {
  TILE_IDS
  const bf16_t* A = (const bf16_t*)(p.ws + OFF_YS);
  const bf16_t* B = (const bf16_t*)(p.ws + OFF_WGLU);
  bf16_t* C = (bf16_t*)(p.ws + OFF_MIX);
  for (int tile = bid; tile < 256 * 8; tile += nb) {
    const int xj = tile >> 3, mt = (xj >> 3) * 8 + (tile & 7), nt = xj & 7;
    ROWS4(ap, A, mt * 128, 512);
    ROWS4(bp, B, nt * 128, 512);
    f32x4 acc[4][4]; acc_zero(acc);
    gemm_core(acc, ap, 64, bp, 64, 8, smem);
#pragma unroll
    for (int m = 0; m < 4; ++m)
#pragma unroll
      for (int n = 0; n < 4; n += 2) {
        const int row = mt * 128 + wr * 64 + m * 16 + fr;
        const int col = (nt * 4 + wc * 2 + (n >> 1)) * 16 + fq * 4;
        f32x4 a = acc[m][n], g = acc[m][n + 1];
        st4bf(C + (size_t)row * 1024 + col, a.x * sigmoid_(g.x), a.y * sigmoid_(g.y), a.z * sigmoid_(g.z), a.w * sigmoid_(g.w));
      }
  }
}
DEVINL void phase_outproj(const Params& p, int bid, int nb, int L, char* smem) {
  TILE_IDS
  const bf16_t* A = (const bf16_t*)(p.ws + OFF_MIX);
  const bf16_t* B = (const bf16_t*)(p.ws + (L == 0 ? OFF_WOUT0 : OFF_WOUT1));
  const float* xin = (L == 0) ? p.in[I_X] : p.out;
  const float* mod = (const float*)(p.ws + OFF_MOD);
  for (int tile = bid; tile < 256 * 8; tile += nb) {
    const int xj = tile >> 3, mt = (xj >> 3) * 8 + (tile & 7), nt = xj & 7;
    ROWS4(ap, A, mt * 128, 1024);
    ROWS4(bp, B, nt * 128, 1024);
    f32x4 acc[4][4]; acc_zero(acc);
    gemm_core(acc, ap, 64, bp, 64, 16, smem);
    const int b = (mt * 128) >> 12;
    const float* gate1 = mod + ((size_t)L * 8 + b) * 6144 + 2 * 1024;
#pragma unroll
    for (int m = 0; m < 4; ++m)
#pragma unroll
      for (int n = 0; n < 4; ++n) {
        const int row = mt * 128 + wr * 64 + m * 16 + fr, col = nt * 128 + wc * 64 + n * 16 + fq * 4;
        f32x4 x = *(const f32x4*)(xin + (size_t)row * 1024 + col), g = *(const f32x4*)(gate1 + col), o;
        o.x = x.x + g.x * acc[m][n].x; o.y = x.y + g.y * acc[m][n].y; o.z = x.z + g.z * acc[m][n].z; o.w = x.w + g.w * acc[m][n].w;
        *(f32x4*)(p.out + (size_t)row * 1024 + col) = o;
      }
  }
}
DEVINL void phase_moe_gu(const Params& p, int bid, int nb, int L, char* smem) {
  TILE_IDS
  int* pad_start = (int*)(smem + 65536 + 64);
  moe_prefix(p, L, pad_start);
  const bf16_t* Hh = (const bf16_t*)(p.ws + OFF_H);
  const bf16_t* W = (const bf16_t*)(p.ws + OFF_WGU);
  const int* list = (const int*)(p.ws + OFF_LIST);
  bf16_t* ACT = (bf16_t*)(p.ws + OFF_ACT);
  const int total = pad_start[32];
  int* sQ = pad_start + 40;
  unsigned* q = (unsigned*)(p.ws + OFF_CTL) + CTL_MOEQ + (L * 2 + 0) * 64;
  const int ntiles = (total >> 7) * 8;
  for (;;) {
    hsync();
    if (tid == 0) sQ[0] = (int)atomicAdd(q, 1u);
    hsync();
    const int tile = sQ[0];
    if (tile >= ntiles) break;
    const int ti = tile >> 3, nt = tile & 7;
    int e = 0;
    while (pad_start[e + 1] <= ti * 128) ++e;
    int tk[4];
    {
      const int cnt_e = ((const int*)(p.ws + OFF_CTL))[CTL_COUNT + (L * 32 + e) * 32], pos0 = ti * 128 - pad_start[e];
#pragma unroll
      for (int i = 0; i < 4; ++i) { const int pos = pos0 + lr + 32 * i; tk[i] = (pos < cnt_e) ? list[(size_t)e * T + pos] : 0; }
    }
    const bf16_t* const ap[4] = {Hh + (size_t)tk[0] * 1024 + lc, Hh + (size_t)tk[1] * 1024 + lc, Hh + (size_t)tk[2] * 1024 + lc, Hh + (size_t)tk[3] * 1024 + lc};
    ROWS4(bp, W, e * 1024 + nt * 128, 1024);
    f32x4 acc[4][4]; acc_zero(acc);
    gemm_core(acc, ap, 64, bp, 64, 16, smem);
#pragma unroll
    for (int m = 0; m < 4; ++m)
#pragma unroll
      for (int n = 0; n < 4; n += 2) {
        const int row = ti * 128 + wr * 64 + m * 16 + fr;
        const int col = (nt * 4 + wc * 2 + (n >> 1)) * 16 + fq * 4;
        f32x4 g = acc[m][n], u = acc[m][n + 1];
        st4bf(ACT + (size_t)row * 512 + col, silu_(g.x) * u.x, silu_(g.y) * u.y, silu_(g.z) * u.z, silu_(g.w) * u.w);
      }
  }
}
DEVINL void phase_moe_down(const Params& p, int bid, int nb, int L, char* smem) {
  TILE_IDS
  int* pad_start = (int*)(smem + 65536 + 64);
  moe_prefix(p, L, pad_start);
  const bf16_t* A = (const bf16_t*)(p.ws + OFF_ACT);
  const bf16_t* W = (const bf16_t*)(p.ws + OFF_WD);
  bf16_t* Y = (bf16_t*)(p.ws + OFF_YEXP);
  const int total = pad_start[32];
  int* sQ = pad_start + 40;
  unsigned* q = (unsigned*)(p.ws + OFF_CTL) + CTL_MOEQ + (L * 2 + 1) * 64;
  const int ntiles = (total >> 7) * 8;
  for (;;) {
    hsync();
    if (tid == 0) sQ[0] = (int)atomicAdd(q, 1u);
    hsync();
    const int tile = sQ[0];
    if (tile >= ntiles) break;
    const int ti = tile >> 3, nt = tile & 7;
    int e = 0;
    while (pad_start[e + 1] <= ti * 128) ++e;
    ROWS4(ap, A, ti * 128, 512);
    ROWS4(bp, W, e * 1024 + nt * 128, 512);
    f32x4 acc[4][4]; acc_zero(acc);
    gemm_core(acc, ap, 64, bp, 64, 8, smem);
#pragma unroll
    for (int m = 0; m < 4; ++m)
#pragma unroll
      for (int n = 0; n < 4; ++n) {
        const int row = ti * 128 + wr * 64 + m * 16 + fr, col = nt * 128 + wc * 64 + n * 16 + fq * 4;
        st4bf(Y + (size_t)row * 1024 + col, acc[m][n].x, acc[m][n].y, acc[m][n].z, acc[m][n].w);
      }
  }
}

DEVINL float gelu_tanh(float x) {
  const float k = 0.7978845608028654f;
  return 0.5f * x * (1.f + tanh_(k * (x + 0.044715f * x * x * x)));
}

DEVINL void phase_s5_a(const Params& p, int bid, int nb, char* smem) {
  TILE_IDS
  const bf16_t* P0 = (const bf16_t*)(p.ws + OFF_PROJ0);
  const bf16_t* F = (const bf16_t*)(p.ws + OFF_S5F);
  float* HLOC = (float*)(p.ws + OFF_HLOC);
  for (int tile = bid; tile < 128; tile += nb) {
    const int g = tile >> 2, mt = tile & 3;
    const bf16_t* a0 = P0 + ((size_t)((mt * 128 + lr) * 64 + (lc >> 4)) * 2048 + g * 16 + (lc & 15));
    const bf16_t* const ap[4] = {a0, a0 + (size_t)32 * 64 * 2048, a0 + (size_t)64 * 64 * 2048, a0 + (size_t)96 * 64 * 2048};
    ROWS4(bp, F, g * 128, 1024);
    f32x4 acc[4][4]; acc_zero(acc);
    gemm_core(acc, ap, 4 * 2048, bp, 64, 16, smem);
#pragma unroll
    for (int m = 0; m < 4; ++m)
#pragma unroll
      for (int n = 0; n < 4; ++n) {
        const int chunk = mt * 128 + wr * 64 + m * 16 + fr, n2 = wc * 64 + n * 16 + fq * 4;
        *(f32x4*)(HLOC + ((size_t)chunk * 32 + g) * 128 + n2) = acc[m][n];
      }
  }
}
DEVINL void phase_s5_scan(const Params& p, int bid, int nb, char* smem) {
  const float* HLOC = (const float*)(p.ws + OFF_HLOC);
  bf16_t* HPREV = (bf16_t*)(p.ws + OFF_HPREV);
  const float* P64 = (const float*)(p.ws + OFF_S5P);
  for (int id = bid * 256 + my_tid(); id < 16384; id += nb * 256) {
    const int n = id & 63, g = (id >> 6) & 31, b = id >> 11;
    const float pr = P64[(g * 64 + n) * 2], pi = P64[(g * 64 + n) * 2 + 1];
    float hr = 0.f, hi = 0.f;
#pragma unroll 8
    for (int c = 0; c < 64; ++c) {
      const size_t base = ((size_t)(b * 64 + c) * 32 + g) * 128;
      HPREV[base + n] = f2bf(hr); HPREV[base + 64 + n] = f2bf(hi);
      const float lr_ = HLOC[base + n], li = HLOC[base + 64 + n];
      const float nr = pr * hr - pi * hi + lr_, ni = pr * hi + pi * hr + li;
      hr = nr; hi = ni;
    }
  }
}
DEVINL void phase_s5_b(const Params& p, int bid, int nb, char* smem) {
  TILE_IDS
  const bf16_t* P0 = (const bf16_t*)(p.ws + OFF_PROJ0);
  const bf16_t* Kx = (const bf16_t*)(p.ws + OFF_S5K);
  const bf16_t* E = (const bf16_t*)(p.ws + OFF_S5E);
  const bf16_t* HPREV = (const bf16_t*)(p.ws + OFF_HPREV);
  bf16_t* YS = (bf16_t*)(p.ws + OFF_YS);
  for (int tile = bid; tile < 1024; tile += nb) {
    const int nt = 7 - (tile >> 7), g = (tile >> 2) & 31, mt = tile & 3;
    const bf16_t* a0 = P0 + ((size_t)((mt * 128 + lr) * 64 + (lc >> 4)) * 2048 + g * 16 + (lc & 15));
    const bf16_t* const ap[4] = {a0, a0 + (size_t)32 * 64 * 2048, a0 + (size_t)64 * 64 * 2048, a0 + (size_t)96 * 64 * 2048};
    const int t0 = nt * 8 + (lr >> 4);
    const bf16_t* b0 = Kx + ((size_t)g * 72 + (t0 - (lc >> 4) + 8)) * 256 + (lr & 15) * 16 + (lc & 15);
    const bf16_t* const bp[4] = {b0, b0 + 2 * 256, b0 + 4 * 256, b0 + 6 * 256};
    f32x4 acc[4][4]; acc_zero(acc);
    gemm_core(acc, ap, 4 * 2048, bp, -1024, 2 * (nt + 1), smem);
    const bf16_t* a0c = HPREV + ((size_t)(mt * 128 + lr) * 32 + g) * 128 + lc;
    const bf16_t* const apc[4] = {a0c, a0c + (size_t)32 * 32 * 128, a0c + (size_t)64 * 32 * 128, a0c + (size_t)96 * 32 * 128};
    ROWS4(bpc, E, g * 1024 + nt * 128, 128);
    gemm_core(acc, apc, 64, bpc, 64, 2, smem);
#pragma unroll
    for (int m = 0; m < 4; ++m)
#pragma unroll
      for (int n = 0; n < 4; ++n) {
        const int chunk = mt * 128 + wr * 64 + m * 16 + fr, t = nt * 8 + wc * 4 + n, pp = fq * 4;
        const size_t row = (size_t)chunk * 64 + t;
        float u[4];
        ld4bf(P0 + row * 2048 + g * 16 + pp, u);
        const float* dsk = p.in[I_S5_D] + g * 16 + pp;
        st4bf(YS + row * 512 + g * 16 + pp, gelu_tanh(acc[m][n].x + dsk[0] * u[0]), gelu_tanh(acc[m][n].y + dsk[1] * u[1]),
              gelu_tanh(acc[m][n].z + dsk[2] * u[2]), gelu_tanh(acc[m][n].w + dsk[3] * u[3]));
      }
  }
}
DEVINL void phase_attn(const Params& p, int bid, int nb, char* smem) {
  const int tid = my_tid(), lane = tid & 63, wid = tid >> 6, fr = lane & 15, fq = lane >> 4;
  bf16_t* sK = (bf16_t*)smem;
  bf16_t* sVt = sK + 64 * 72;
  bf16_t* sLh = sVt + 64 * 72 + wid * (3 * 16 * 72);
  bf16_t* sLl = sLh + 16 * 72;
  bf16_t* sW = sLl + 16 * 72;
  int* sFlag = (int*)(smem + 46080);
  const bf16_t* P0 = (const bf16_t*)(p.ws + OFF_PROJ0);
  bf16_t* MIX = (bf16_t*)(p.ws + OFF_MIX);
  bf16x8 tri[6];
  {
    const int combos[6][2] = {{0, 0}, {0, 1}, {1, 0}, {1, 1}, {2, 1}, {3, 1}};
#pragma unroll
    for (int c = 0; c < 6; ++c)
#pragma unroll
      for (int e = 0; e < 8; ++e) tri[c][e] = (combos[c][1] * 32 + fq * 8 + e >= combos[c][0] * 16 + fr) ? (short)0x3F80 : (short)0;
  }
  int* sTask = sFlag + 4;
  unsigned* q = (unsigned*)(p.ws + OFF_CTL) + CTL_ATTQ;
  if (tid == 0) sTask[0] = (int)atomicAdd(q, 1u);
  hsync();
  int task = sTask[0];
  while (task < 4096) {
    hsync();
    if (tid == 0) sTask[0] = (int)atomicAdd(q, 1u);
    const int bh = task & 63, qt = 63 - (task >> 6);
    const int b = bh >> 3, h = bh & 7;
    const int tq = qt * 64 + wid * 16 + fr;
    bf16x8 qf[2];
#pragma unroll
    for (int kk = 0; kk < 2; ++kk) {
      float q[8];
      ld8bf(P0 + ((size_t)b * SEQ + tq) * 2048 + 512 + h * 64 + kk * 32 + fq * 8, q);
#pragma unroll
      for (int e = 0; e < 8; ++e) qf[kk][e] = (short)f2bf(q[e] * 0.125f);
    }
    f32x4 o[4];
#pragma unroll
    for (int dt = 0; dt < 4; ++dt) o[dt] = (f32x4){0.f, 0.f, 0.f, 0.f};
    float R = 0.f;
    u32x4 gk[2], gv[2];
#pragma unroll
    for (int i = 0; i < 2; ++i) {
      const int id = tid + 256 * i, s_ = id >> 3, d0 = (id & 7) * 8;
      const bf16_t* src = P0 + ((size_t)b * SEQ + qt * 64 + s_) * 2048 + 1024 + h * 64 + d0;
      gk[i] = *(const u32x4*)src; gv[i] = *(const u32x4*)(src + 512);
    }
    for (int kb = qt; kb >= 0; --kb) {
#pragma unroll
      for (int i = 0; i < 2; ++i) {
        const int id = tid + 256 * i, s_ = id >> 3, d0 = (id & 7) * 8;
        *(u32x4*)(sK + s_ * 72 + d0) = gk[i];
        const unsigned w4[4] = {gv[i].x, gv[i].y, gv[i].z, gv[i].w};
#pragma unroll
        for (int j = 0; j < 4; ++j) { sVt[(d0 + 2 * j) * 72 + s_] = (bf16_t)(w4[j] & 0xffffu); sVt[(d0 + 2 * j + 1) * 72 + s_] = (bf16_t)(w4[j] >> 16); }
      }
      if (kb > 0) {
#pragma unroll
        for (int i = 0; i < 2; ++i) {
          const int id = tid + 256 * i, s_ = id >> 3, d0 = (id & 7) * 8;
          const bf16_t* src = P0 + ((size_t)b * SEQ + (kb - 1) * 64 + s_) * 2048 + 1024 + h * 64 + d0;
          gk[i] = *(const u32x4*)src; gv[i] = *(const u32x4*)(src + 512);
        }
      }
      hsync();
      f32x4 z[4];
#pragma unroll
      for (int nt = 0; nt < 4; ++nt) z[nt] = (f32x4){0.f, 0.f, 0.f, 0.f};
#pragma unroll
      for (int kk = 0; kk < 2; ++kk)
#pragma unroll
        for (int nt = 0; nt < 4; ++nt) {
          const bf16x8 kf = *(const bf16x8*)(sK + (nt * 16 + fr) * 72 + kk * 32 + fq * 8);
          z[nt] = __builtin_amdgcn_mfma_f32_16x16x32_bf16(kf, qf[kk], z[nt], 0, 0, 0);
        }
      const bool diag = (kb == qt);
#pragma unroll
      for (int nt = 0; nt < 4; ++nt) {
        float zz[4] = {z[nt].x, z[nt].y, z[nt].z, z[nt].w}, lk[4], hi[4], lo[4];
#pragma unroll
        for (int j = 0; j < 4; ++j) {
          const int sg = kb * 64 + nt * 16 + fq * 4 + j;
          const bool valid = !diag || (sg < tq);
          lk[j] = valid ? -(fmaxf(zz[j], 0.f) + __logf(1.f + __expf(-fabsf(zz[j])))) : 0.f;
          hi[j] = bf2f(f2bf(lk[j]));
          lo[j] = lk[j] - hi[j];
        }
        st4bf(sLh + fr * 72 + nt * 16 + fq * 4, hi[0], hi[1], hi[2], hi[3]);
        st4bf(sLl + fr * 72 + nt * 16 + fq * 4, lo[0], lo[1], lo[2], lo[3]);
      }
      __builtin_amdgcn_wave_barrier();
      f32x4 sf[4];
#pragma unroll
      for (int nt = 0; nt < 4; ++nt) sf[nt] = (f32x4){R, R, R, R};
      {
        const bf16x8 lh0 = *(const bf16x8*)(sLh + fr * 72 + fq * 8), lh1 = *(const bf16x8*)(sLh + fr * 72 + 32 + fq * 8);
        const bf16x8 ll0 = *(const bf16x8*)(sLl + fr * 72 + fq * 8), ll1 = *(const bf16x8*)(sLl + fr * 72 + 32 + fq * 8);
        sf[0] = __builtin_amdgcn_mfma_f32_16x16x32_bf16(tri[0], lh0, sf[0], 0, 0, 0);
        sf[0] = __builtin_amdgcn_mfma_f32_16x16x32_bf16(tri[0], ll0, sf[0], 0, 0, 0);
        sf[0] = __builtin_amdgcn_mfma_f32_16x16x32_bf16(tri[1], lh1, sf[0], 0, 0, 0);
        sf[0] = __builtin_amdgcn_mfma_f32_16x16x32_bf16(tri[1], ll1, sf[0], 0, 0, 0);
        sf[1] = __builtin_amdgcn_mfma_f32_16x16x32_bf16(tri[2], lh0, sf[1], 0, 0, 0);
        sf[1] = __builtin_amdgcn_mfma_f32_16x16x32_bf16(tri[2], ll0, sf[1], 0, 0, 0);
        sf[1] = __builtin_amdgcn_mfma_f32_16x16x32_bf16(tri[3], lh1, sf[1], 0, 0, 0);
        sf[1] = __builtin_amdgcn_mfma_f32_16x16x32_bf16(tri[3], ll1, sf[1], 0, 0, 0);
        sf[2] = __builtin_amdgcn_mfma_f32_16x16x32_bf16(tri[4], lh1, sf[2], 0, 0, 0);
        sf[2] = __builtin_amdgcn_mfma_f32_16x16x32_bf16(tri[4], ll1, sf[2], 0, 0, 0);
        sf[3] = __builtin_amdgcn_mfma_f32_16x16x32_bf16(tri[5], lh1, sf[3], 0, 0, 0);
        sf[3] = __builtin_amdgcn_mfma_f32_16x16x32_bf16(tri[5], ll1, sf[3], 0, 0, 0);
      }
#pragma unroll
      for (int nt = 0; nt < 4; ++nt) {
        const float zz[4] = {z[nt].x, z[nt].y, z[nt].z, z[nt].w}, ss[4] = {sf[nt].x, sf[nt].y, sf[nt].z, sf[nt].w};
        float w[4];
#pragma unroll
        for (int j = 0; j < 4; ++j) {
          const int sg = kb * 64 + nt * 16 + fq * 4 + j;
          const bool valid = !diag || (sg < tq);
          w[j] = valid ? __expf(zz[j] + ss[j]) : 0.f;
        }
        st4bf(sW + fr * 72 + nt * 16 + fq * 4, w[0], w[1], w[2], w[3]);
      }
      R = __shfl(sf[0].x, fr);
      __builtin_amdgcn_wave_barrier();
#pragma unroll
      for (int kk = 0; kk < 2; ++kk) {
        const bf16x8 wf = *(const bf16x8*)(sW + fr * 72 + kk * 32 + fq * 8);
#pragma unroll
        for (int dt = 0; dt < 4; ++dt) {
          const bf16x8 vf = *(const bf16x8*)(sVt + (dt * 16 + fr) * 72 + kk * 32 + fq * 8);
          o[dt] = __builtin_amdgcn_mfma_f32_16x16x32_bf16(vf, wf, o[dt], 0, 0, 0);
        }
      }
      const int done = __all(R < -104.f);
      if (lane == 0) sFlag[wid] = done;
      hsync();
      if (sFlag[0] && sFlag[1] && sFlag[2] && sFlag[3]) break;
    }
#pragma unroll
    for (int dt = 0; dt < 4; ++dt)
      st4bf(MIX + ((size_t)b * SEQ + tq) * 1024 + 512 + h * 64 + dt * 16 + fq * 4, o[dt].x, o[dt].y, o[dt].z, o[dt].w);
    hsync();
    task = sTask[0];
  }
}

DEVINL void phase_rwkv_pre(const Params& p, int bid, int nb, char* smem) {
  const int tid = my_tid(), lane = tid & 63, wid = tid >> 6;
  const bf16_t* PR = (const bf16_t*)(p.ws + OFF_PROJR);
  bf16_t* KP = (bf16_t*)(p.ws + OFF_RKP);
  bf16_t* KK = (bf16_t*)(p.ws + OFF_RKK);
  bf16_t* LW = (bf16_t*)(p.ws + OFF_LORAW);
  bf16_t* LA = (bf16_t*)(p.ws + OFF_LORAA);
  bf16_t* LG = (bf16_t*)(p.ws + OFF_LORAG);
  const float* mu = p.in[I_RW_MU];
  float mu_k[8], wkk[8], mu_l[8];
  const int ck = lane * 8, cl = (lane & 31) * 8;
#pragma unroll
  for (int j = 0; j < 8; ++j) { mu_k[j] = mu[512 + ck + j]; wkk[j] = p.in[I_RW_KK][ck + j]; mu_l[j] = mu[1536 + cl + j]; }
  const int nwaves = nb * 4;
  for (int pr = bid * 4 + wid; pr < T / 2; pr += nwaves) {
#pragma unroll
    for (int tk = 0; tk < 2; ++tk) {
      const int row = pr * 2 + tk;
      const bool first = (row & (SEQ - 1)) == 0;
      float c[8], q[8] = {0.f, 0.f, 0.f, 0.f, 0.f, 0.f, 0.f, 0.f};
      ld8bf(PR + (size_t)row * 1792 + 512 + ck, c);
      if (!first) ld8bf(PR + (size_t)(row - 1) * 1792 + 512 + ck, q);
      float km[8], kv[8], ss = 0.f;
#pragma unroll
      for (int j = 0; j < 8; ++j) { km[j] = c[j] + (q[j] - c[j]) * mu_k[j]; kv[j] = km[j] * wkk[j]; ss += kv[j] * kv[j]; }
      ss += __shfl_xor(ss, 1); ss += __shfl_xor(ss, 2); ss += __shfl_xor(ss, 4);
      const float inv = 1.f / fmaxf(sqrtf(ss), 1e-12f);
      u32x4 o;
      o.x = pk2(km[0], km[1]); o.y = pk2(km[2], km[3]); o.z = pk2(km[4], km[5]); o.w = pk2(km[6], km[7]);
      *(u32x4*)(KP + (size_t)row * 512 + ck) = o;
      o.x = pk2(kv[0] * inv, kv[1] * inv); o.y = pk2(kv[2] * inv, kv[3] * inv); o.z = pk2(kv[4] * inv, kv[5] * inv); o.w = pk2(kv[6] * inv, kv[7] * inv);
      *(u32x4*)(KK + (size_t)row * 512 + ck) = o;
    }
    {
      const int row = pr * 2 + (lane >> 5), l5 = lane & 31;
      const bool first = (row & (SEQ - 1)) == 0;
      float c[8], q[8] = {0.f, 0.f, 0.f, 0.f, 0.f, 0.f, 0.f, 0.f}, m[8];
      ld8bf(PR + (size_t)row * 1792 + 1536 + cl, c);
      if (!first) ld8bf(PR + (size_t)(row - 1) * 1792 + 1536 + cl, q);
#pragma unroll
      for (int j = 0; j < 8; ++j) {
        const float x = c[j] + (q[j] - c[j]) * mu_l[j];
        m[j] = (l5 < 8) ? tanh_(x) : (l5 < 16) ? x : sigmoid_(x);
      }
      u32x4 o;
      o.x = pk2(m[0], m[1]); o.y = pk2(m[2], m[3]); o.z = pk2(m[4], m[5]); o.w = pk2(m[6], m[7]);
      bf16_t* dst = (l5 < 8) ? (LW + (size_t)row * 64 + l5 * 8) : (l5 < 16) ? (LA + (size_t)row * 64 + (l5 - 8) * 8) : (LG + (size_t)row * 128 + (l5 - 16) * 8);
      *(u32x4*)dst = o;
    }
  }
}
DEVINL void phase_rwkv_lora01(const Params& p, int bid, int nb) {
  const int tid = my_tid(), lane = tid & 63, wid = tid >> 6, fr = lane & 15, fq = lane >> 4;
  bf16_t* WE = (bf16_t*)(p.ws + OFF_RWE);
  bf16_t* RA = (bf16_t*)(p.ws + OFF_RA);
  bf16_t* KP = (bf16_t*)(p.ws + OFF_RKP);
  for (int wt = bid * 4 + wid; wt < 1024; wt += nb * 4) {
    const int which = wt & 1, rg = wt >> 1;
    const bf16_t* A = (const bf16_t*)(p.ws + (which == 0 ? OFF_LORAW : OFF_LORAA));
    const bf16_t* B = (const bf16_t*)(p.ws + (which == 0 ? OFF_W2T : OFF_A2T));
    bf16x8 af[4][2];
#pragma unroll
    for (int m = 0; m < 4; ++m)
#pragma unroll
      for (int kk = 0; kk < 2; ++kk) af[m][kk] = *(const bf16x8*)(A + (size_t)(rg * 64 + m * 16 + fr) * 64 + kk * 32 + fq * 8);
#pragma unroll 1
    for (int cg = 0; cg < 8; ++cg) {
      f32x4 acc[4][4];
#pragma unroll
      for (int m = 0; m < 4; ++m)
#pragma unroll
        for (int n = 0; n < 4; ++n) acc[m][n] = (f32x4){0.f, 0.f, 0.f, 0.f};
#pragma unroll
      for (int kk = 0; kk < 2; ++kk)
#pragma unroll
        for (int n = 0; n < 4; ++n) {
          const bf16x8 bf = *(const bf16x8*)(B + (size_t)(cg * 64 + n * 16 + fr) * 64 + kk * 32 + fq * 8);
#pragma unroll
          for (int m = 0; m < 4; ++m) acc[m][n] = __builtin_amdgcn_mfma_f32_16x16x32_bf16(bf, af[m][kk], acc[m][n], 0, 0, 0);
        }
      if (which == 0) {
#pragma unroll
        for (int n = 0; n < 4; ++n) {
          const int col = cg * 64 + n * 16 + fq * 4;
          const f32x4 w0 = *(const f32x4*)(p.in[I_RW_W0] + col);
#pragma unroll
          for (int m = 0; m < 4; ++m) {
            const int row = rg * 64 + m * 16 + fr;
            const f32x4 a = acc[m][n];
            st4bf(WE + (size_t)row * 512 + col, __expf(-softplus_(-(w0.x + a.x)) - 0.5f), __expf(-softplus_(-(w0.y + a.y)) - 0.5f),
                  __expf(-softplus_(-(w0.z + a.z)) - 0.5f), __expf(-softplus_(-(w0.w + a.w)) - 0.5f));
          }
        }
      } else {
#pragma unroll
        for (int n = 0; n < 4; ++n) {
          const int col = cg * 64 + n * 16 + fq * 4;
          const f32x4 a0 = *(const f32x4*)(p.in[I_RW_A0] + col), ka = *(const f32x4*)(p.in[I_RW_KA] + col);
#pragma unroll
          for (int m = 0; m < 4; ++m) {
            const int row = rg * 64 + m * 16 + fr;
            float km[4];
            ld4bf(KP + (size_t)row * 512 + col, km);
            const float s0 = sigmoid_(a0.x + acc[m][n].x), s1 = sigmoid_(a0.y + acc[m][n].y), s2 = sigmoid_(a0.z + acc[m][n].z), s3 = sigmoid_(a0.w + acc[m][n].w);
            st4bf(RA + (size_t)row * 512 + col, s0, s1, s2, s3);
            st4bf(KP + (size_t)row * 512 + col, km[0] * (1.f + (s0 - 1.f) * ka.x), km[1] * (1.f + (s1 - 1.f) * ka.y), km[2] * (1.f + (s2 - 1.f) * ka.z), km[3] * (1.f + (s3 - 1.f) * ka.w));
          }
        }
      }
    }
  }
}
DEVINL void phase_rwkv_lora(const Params& p, int bid, int nb, int which, char* smem) {
  TILE_IDS
  const int K = (which == 2) ? 128 : 64;
  const bf16_t* A = (const bf16_t*)(p.ws + (which == 0 ? OFF_LORAW : which == 1 ? OFF_LORAA : OFF_LORAG));
  const bf16_t* B = (const bf16_t*)(p.ws + (which == 0 ? OFF_W2T : which == 1 ? OFF_A2T : OFF_G2T));
  bf16_t* WE = (bf16_t*)(p.ws + OFF_RWE);
  bf16_t* RA = (bf16_t*)(p.ws + OFF_RA);
  bf16_t* KP = (bf16_t*)(p.ws + OFF_RKP);
  for (int tile = bid; tile < 256 * 4; tile += nb) {
    const int mt = tile >> 2, nt = tile & 3;
    ROWS4(ap, A, mt * 128, K);
    ROWS4(bp, B, nt * 128, K);
    f32x4 acc[4][4]; acc_zero(acc);
    gemm_core(acc, ap, 64, bp, 64, K / 64, smem);
    if (which == 0) {
#pragma unroll
      for (int n = 0; n < 4; ++n) {
        const int col = nt * 128 + wc * 64 + n * 16 + fq * 4;
        const f32x4 w0 = *(const f32x4*)(p.in[I_RW_W0] + col);
#pragma unroll
        for (int m = 0; m < 4; ++m) {
          const int row = mt * 128 + wr * 64 + m * 16 + fr;
          const f32x4 a = acc[m][n];
          st4bf(WE + (size_t)row * 512 + col, __expf(-softplus_(-(w0.x + a.x)) - 0.5f), __expf(-softplus_(-(w0.y + a.y)) - 0.5f),
                __expf(-softplus_(-(w0.z + a.z)) - 0.5f), __expf(-softplus_(-(w0.w + a.w)) - 0.5f));
        }
      }
    } else if (which == 1) {
#pragma unroll
      for (int n = 0; n < 4; ++n) {
        const int col = nt * 128 + wc * 64 + n * 16 + fq * 4;
        const f32x4 a0 = *(const f32x4*)(p.in[I_RW_A0] + col), ka = *(const f32x4*)(p.in[I_RW_KA] + col);
#pragma unroll
        for (int m = 0; m < 4; ++m) {
          const int row = mt * 128 + wr * 64 + m * 16 + fr;
          float km[4];
          ld4bf(KP + (size_t)row * 512 + col, km);
          const float s0 = sigmoid_(a0.x + acc[m][n].x), s1 = sigmoid_(a0.y + acc[m][n].y), s2 = sigmoid_(a0.z + acc[m][n].z), s3 = sigmoid_(a0.w + acc[m][n].w);
          st4bf(RA + (size_t)row * 512 + col, s0, s1, s2, s3);
          st4bf(KP + (size_t)row * 512 + col, km[0] * (1.f + (s0 - 1.f) * ka.x), km[1] * (1.f + (s1 - 1.f) * ka.y), km[2] * (1.f + (s2 - 1.f) * ka.z), km[3] * (1.f + (s3 - 1.f) * ka.w));
        }
      }
    } else {
      const bf16_t* PR = (const bf16_t*)(p.ws + OFF_PROJR);
      bf16_t* MIX = (bf16_t*)(p.ws + OFF_MIX);
      const bf16_t* YR = (const bf16_t*)(p.ws + OFF_RA);
      const float* mu = p.in[I_RW_MU];
#pragma unroll
      for (int m = 0; m < 4; ++m) {
        const int row = mt * 128 + wr * 64 + m * 16 + fr;
        const bool first = (row & (SEQ - 1)) == 0;
        float sy = 0.f, sy2 = 0.f, sb = 0.f;
#pragma unroll
        for (int n = 0; n < 4; ++n) {
          const int col = nt * 128 + wc * 64 + n * 16 + fq * 4;
          const f32x4 mu4 = *(const f32x4*)(mu + col), rk4 = *(const f32x4*)(p.in[I_RW_RK] + col);
          const float mu_[4] = {mu4.x, mu4.y, mu4.z, mu4.w}, rk_[4] = {rk4.x, rk4.y, rk4.z, rk4.w};
          float y[4], kq[4], rc[4], rp[4] = {0.f, 0.f, 0.f, 0.f};
          ld4bf(YR + (size_t)row * 512 + col, y);
          ld4bf(KP + (size_t)row * 512 + col, kq);
          ld4bf(PR + (size_t)row * 1792 + col, rc);
          if (!first) ld4bf(PR + (size_t)(row - 1) * 1792 + col, rp);
#pragma unroll
          for (int j = 0; j < 4; ++j) {
            const float rm = rc[j] + (rp[j] - rc[j]) * mu_[j];
            sy += y[j]; sy2 += y[j] * y[j];
            sb += rm * kq[j] * rk_[j];
          }
        }
        sy += __shfl_xor(sy, 16); sy += __shfl_xor(sy, 32);
        sy2 += __shfl_xor(sy2, 16); sy2 += __shfl_xor(sy2, 32);
        sb += __shfl_xor(sb, 16); sb += __shfl_xor(sb, 32);
        const float mean = sy * (1.f / 64.f);
        const float var = fmaxf(sy2 * (1.f / 64.f) - mean * mean, 0.f);
        const float rstd = rsqrtf(var + 64e-5f);
#pragma unroll
        for (int n = 0; n < 4; ++n) {
          const int col = nt * 128 + wc * 64 + n * 16 + fq * 4;
          const f32x4 mv4 = *(const f32x4*)(mu + 1024 + col), lw4 = *(const f32x4*)(p.in[I_RW_LNW] + col), lb4 = *(const f32x4*)(p.in[I_RW_LNB] + col);
          const float mv_[4] = {mv4.x, mv4.y, mv4.z, mv4.w}, lw_[4] = {lw4.x, lw4.y, lw4.z, lw4.w}, lb_[4] = {lb4.x, lb4.y, lb4.z, lb4.w};
          float y[4], vc[4], vp[4] = {0.f, 0.f, 0.f, 0.f};
          ld4bf(YR + (size_t)row * 512 + col, y);
          ld4bf(PR + (size_t)row * 1792 + 1024 + col, vc);
          if (!first) ld4bf(PR + (size_t)(row - 1) * 1792 + 1024 + col, vp);
          const float g4[4] = {acc[m][n].x, acc[m][n].y, acc[m][n].z, acc[m][n].w};
          float o[4];
#pragma unroll
          for (int j = 0; j < 4; ++j) {
            const float vm = vc[j] + (vp[j] - vc[j]) * mv_[j];
            o[j] = ((y[j] - mean) * rstd * lw_[j] + lb_[j] + sb * vm) * g4[j];
          }
          st4bf(MIX + (size_t)row * 1024 + col, o[0], o[1], o[2], o[3]);
        }
      }
    }
  }
}
DEVINL void phase_m2_pre(const Params& p, int bid, int nb, char* smem) {
  const bf16_t* PM = (const bf16_t*)(p.ws + OFF_PROJM);
  bf16_t* XBC = (bf16_t*)(p.ws + OFF_XBC);
  const float* cw = p.in[I_M2_CONVW];
  const float* cb = p.in[I_M2_CONVB];
  const int c = (my_tid() & 127) * 8, grp = my_tid() >> 7;
  float w[4][8], bias[8];
#pragma unroll
  for (int j = 0; j < 8; ++j) { bias[j] = cb[c + j]; w[0][j] = cw[c + j]; w[1][j] = cw[1024 + c + j]; w[2][j] = cw[2048 + c + j]; w[3][j] = cw[3072 + c + j]; }
  for (int it = bid * 2 + grp; it < T / 16; it += nb * 2) {
    const int row0 = it * 16, t0 = row0 & (SEQ - 1);
    float x0[8], x1[8], x2[8], x3[8];
    if (t0 > 0) {
      ld8bf(PM + (size_t)(row0 - 3) * 1664 + 512 + c, x0);
      ld8bf(PM + (size_t)(row0 - 2) * 1664 + 512 + c, x1);
      ld8bf(PM + (size_t)(row0 - 1) * 1664 + 512 + c, x2);
    } else {
#pragma unroll
      for (int j = 0; j < 8; ++j) { x0[j] = 0.f; x1[j] = 0.f; x2[j] = 0.f; }
    }
#pragma unroll 4
    for (int tt = 0; tt < 16; ++tt) {
      ld8bf(PM + (size_t)(row0 + tt) * 1664 + 512 + c, x3);
      float o[8];
#pragma unroll
      for (int j = 0; j < 8; ++j) {
        o[j] = silu_(bias[j] + w[0][j] * x0[j] + w[1][j] * x1[j] + w[2][j] * x2[j] + w[3][j] * x3[j]);
        x0[j] = x1[j]; x1[j] = x2[j]; x2[j] = x3[j];
      }
      u32x4 v;
      v.x = pk2(o[0], o[1]); v.y = pk2(o[2], o[3]); v.z = pk2(o[4], o[5]); v.w = pk2(o[6], o[7]);
      *(u32x4*)(XBC + (size_t)(row0 + tt) * 1024 + c) = v;
    }
  }
  const float* DR = (const float*)(p.ws + OFF_DTRAW);
  float* DV = (float*)(p.ws + OFF_DTV);
  for (int i = bid * 256 + my_tid(); i < T * 8; i += nb * 256) DV[i] = softplus_(DR[i] + p.in[I_M2_DTB][i & 7]);
}
DEVINL float wave_incl_scan(float v, int lane) {
#pragma unroll
  for (int o = 1; o < 64; o <<= 1) { float t = __shfl_up(v, o); if (lane >= o) v += t; }
  return v;
}
DEVINL void phase_ssd_a(const Params& p, int bid, int nb, char* smem) {
  const int tid = my_tid(), lane = tid & 63, wid = tid >> 6, fr = lane & 15, fq = lane >> 4;
  bf16_t* sBT = (bf16_t*)smem;
  bf16_t* sXT = sBT + 128 * 72;
  float* sSc = (float*)(sXT + 64 * 72);
  const bf16_t* XBC = (const bf16_t*)(p.ws + OFF_XBC);
  const float* DV = (const float*)(p.ws + OFF_DTV);
  bf16_t* ST = (bf16_t*)(p.ws + OFF_ST);
  float* ATOT = (float*)(p.ws + OFF_ATOT);
  for (int task = bid; task < 1024; task += nb) {
    const int bc = task >> 1, gi = task & 1;
    const size_t row0 = (size_t)bc * 64;
#pragma unroll
    for (int i = 0; i < 4; ++i) {
      const int id = tid + 256 * i, l = id >> 4, n0 = (id & 15) * 8;
      u32x4 v = *(const u32x4*)(XBC + (row0 + l) * 1024 + 512 + gi * 128 + n0);
      const unsigned w[4] = {v.x, v.y, v.z, v.w};
#pragma unroll
      for (int j = 0; j < 4; ++j) { sBT[(n0 + 2 * j) * 72 + l] = (bf16_t)(w[j] & 0xffffu); sBT[(n0 + 2 * j + 1) * 72 + l] = (bf16_t)(w[j] >> 16); }
    }
    for (int hh = 0; hh < 4; ++hh) {
      const int h = gi * 4 + hh;
      const float a = -expf(p.in[I_M2_ALOG][h]);
      const float dt = DV[(row0 + lane) * 8 + h];
      const float acs = wave_incl_scan(a * dt, lane);
      const float tot = __shfl(acs, 63);
      if (wid == 0) { sSc[lane] = dt * expf(tot - acs); if (lane == 63) ATOT[bc * 8 + h] = tot; }
      hsync();
#pragma unroll
      for (int i = 0; i < 2; ++i) {
        const int id = tid + 256 * i, l = id >> 3, p0 = (id & 7) * 8;
        float x[8];
        ld8bf(XBC + (row0 + l) * 1024 + h * 64 + p0, x);
        const float sc = sSc[l];
#pragma unroll
        for (int j = 0; j < 8; ++j) sXT[(p0 + j) * 72 + l] = f2bf(x[j] * sc);
      }
      hsync();
      f32x4 acc[8];
#pragma unroll
      for (int nt = 0; nt < 8; ++nt) acc[nt] = (f32x4){0.f, 0.f, 0.f, 0.f};
#pragma unroll
      for (int kk = 0; kk < 2; ++kk) {
        const bf16x8 af = *(const bf16x8*)(sXT + (wid * 16 + fr) * 72 + kk * 32 + fq * 8);
#pragma unroll
        for (int nt = 0; nt < 8; ++nt) {
          const bf16x8 bf = *(const bf16x8*)(sBT + (nt * 16 + fr) * 72 + kk * 32 + fq * 8);
          acc[nt] = __builtin_amdgcn_mfma_f32_16x16x32_bf16(bf, af, acc[nt], 0, 0, 0);
        }
      }
      bf16_t* dst = ST + ((size_t)bc * 8 + h) * 8192 + (wid * 16 + fr) * 128 + fq * 4;
#pragma unroll
      for (int nt = 0; nt < 8; ++nt) st4bf(dst + nt * 16, acc[nt].x, acc[nt].y, acc[nt].z, acc[nt].w);
      hsync();
    }
  }
}
DEVINL void phase_ssd_b(const Params& p, int bid, int nb, char* smem) {
  bf16_t* ST = (bf16_t*)(p.ws + OFF_ST);
  const float* ATOT = (const float*)(p.ws + OFF_ATOT);
  for (int id = bid * 256 + my_tid(); id < 65536; id += nb * 256) {
    const int n8 = id & 15, pp = (id >> 4) & 63, h = (id >> 10) & 7, b = id >> 13;
    float run[8];
#pragma unroll
    for (int j = 0; j < 8; ++j) run[j] = 0.f;
#pragma unroll 8
    for (int c = 0; c < 64; ++c) {
      bf16_t* ptr = ST + ((size_t)(b * 64 + c) * 8 + h) * 8192 + pp * 128 + n8 * 8;
      float loc[8];
      ld8bf(ptr, loc);
      u32x4 o; o.x = pk2(run[0], run[1]); o.y = pk2(run[2], run[3]); o.z = pk2(run[4], run[5]); o.w = pk2(run[6], run[7]);
      *(u32x4*)ptr = o;
      const float dec = expf(ATOT[(b * 64 + c) * 8 + h]);
#pragma unroll
      for (int j = 0; j < 8; ++j) run[j] = dec * run[j] + loc[j];
    }
  }
}
DEVINL void phase_ssd_c(const Params& p, int bid, int nb, char* smem) {
  const int tid = my_tid(), lane = tid & 63, wid = tid >> 6, fr = lane & 15, fq = lane >> 4;
  bf16_t* sS = (bf16_t*)smem;
  bf16_t* sM = sS + 64 * 136;
  bf16_t* sX = sM + 64 * 72;
  float* sAcs = (float*)(sX + 64 * 72);
  float* sDt = sAcs + 64;
  const bf16_t* XBC = (const bf16_t*)(p.ws + OFF_XBC);
  const bf16_t* PM = (const bf16_t*)(p.ws + OFF_PROJM);
  const float* DV = (const float*)(p.ws + OFF_DTV);
  const bf16_t* ST = (const bf16_t*)(p.ws + OFF_ST);
  bf16_t* MIX = (bf16_t*)(p.ws + OFF_MIX);
  unsigned* q = (unsigned*)(p.ws + OFF_CTL) + CTL_SSDQ;
  int* sQ = (int*)(smem + 65536 + 64 + 176);
  for (;;) {
    hsync();
    if (tid == 0) sQ[0] = (int)atomicAdd(q, 1u);
    hsync();
    const int task = sQ[0];
    if (task >= 1024) break;
    const int bc = task >> 1, gi = task & 1;
    const size_t row0 = (size_t)bc * 64;
    const int l = wid * 16 + fr;
    struct HeadIn { u32x4 st[4]; u32x4 xr[2]; float dt; };
    auto load_head = [&](HeadIn& hin, int h) {
      const bf16_t* src = ST + ((size_t)bc * 8 + h) * 8192;
#pragma unroll
      for (int i = 0; i < 4; ++i) { const int id = tid + 256 * i, pp = id >> 4, n0 = (id & 15) * 8; hin.st[i] = *(const u32x4*)(src + pp * 128 + n0); }
#pragma unroll
      for (int i = 0; i < 2; ++i) { const int id = tid + 256 * i, s_ = id >> 3, p0 = (id & 7) * 8; hin.xr[i] = *(const u32x4*)(XBC + (row0 + s_) * 1024 + h * 64 + p0); }
      hin.dt = DV[(row0 + lane) * 8 + h];
    };
    HeadIn cur;
    load_head(cur, gi * 4);
    bf16x8 cf[4];
#pragma unroll
    for (int kk = 0; kk < 4; ++kk) cf[kk] = *(const bf16x8*)(XBC + (row0 + l) * 1024 + 768 + gi * 128 + kk * 32 + fq * 8);
    f32x4 G[4];
#pragma unroll
    for (int nt = 0; nt < 4; ++nt) G[nt] = (f32x4){0.f, 0.f, 0.f, 0.f};
#pragma unroll
    for (int kk = 0; kk < 4; ++kk)
#pragma unroll
      for (int nt = 0; nt < 4; ++nt) {
        const bf16x8 bf = *(const bf16x8*)(XBC + (row0 + nt * 16 + fr) * 1024 + 512 + gi * 128 + kk * 32 + fq * 8);
        G[nt] = __builtin_amdgcn_mfma_f32_16x16x32_bf16(bf, cf[kk], G[nt], 0, 0, 0);
      }
    float ss = 0.f;
#pragma unroll 1
    for (int hh = 0; hh < 4; ++hh) {
      const int h = gi * 4 + hh;
      const float a = -expf(p.in[I_M2_ALOG][h]);
      const float Dh = p.in[I_M2_D][h];
      const float dt = cur.dt;
      const float acs = wave_incl_scan(a * dt, lane);
      if (wid == 0) { sAcs[lane] = acs; sDt[lane] = dt; }
#pragma unroll
      for (int i = 0; i < 4; ++i) { const int id = tid + 256 * i, pp = id >> 4, n0 = (id & 15) * 8; *(u32x4*)(sS + pp * 136 + n0) = cur.st[i]; }
      hsync();
#pragma unroll
      for (int i = 0; i < 2; ++i) {
        const int id = tid + 256 * i, s_ = id >> 3, p0 = (id & 7) * 8;
        const u32x4 xv = cur.xr[i];
        const float x[8] = {lo2f(xv.x), hi2f(xv.x), lo2f(xv.y), hi2f(xv.y), lo2f(xv.z), hi2f(xv.z), lo2f(xv.w), hi2f(xv.w)};
        const float d = sDt[s_];
#pragma unroll
        for (int j = 0; j < 8; ++j) sX[(p0 + j) * 72 + s_] = f2bf(x[j] * d);
      }
      {
        const float al = sAcs[l];
#pragma unroll
        for (int nt = 0; nt < 4; ++nt) {
          float m[4];
          const float g4[4] = {G[nt].x, G[nt].y, G[nt].z, G[nt].w};
#pragma unroll
          for (int j = 0; j < 4; ++j) {
            const int s_ = nt * 16 + fq * 4 + j;
            m[j] = (s_ <= l) ? g4[j] * __expf(al - sAcs[s_]) : 0.f;
          }
          st4bf(sM + l * 72 + nt * 16 + fq * 4, m[0], m[1], m[2], m[3]);
        }
      }
      HeadIn nxt;
      load_head(nxt, (hh < 3) ? h + 1 : h);
      u32x2 ex[4], ez[4];
#pragma unroll
      for (int pt = 0; pt < 4; ++pt) {
        ex[pt] = *(const u32x2*)(XBC + (row0 + l) * 1024 + h * 64 + pt * 16 + fq * 4);
        ez[pt] = *(const u32x2*)(PM + (row0 + l) * 1664 + h * 64 + pt * 16 + fq * 4);
      }
      hsync();
      f32x4 acc[4];
#pragma unroll
      for (int pt = 0; pt < 4; ++pt) acc[pt] = (f32x4){0.f, 0.f, 0.f, 0.f};
#pragma unroll
      for (int kk = 0; kk < 4; ++kk)
#pragma unroll
        for (int pt = 0; pt < 4; ++pt) {
          const bf16x8 sf = *(const bf16x8*)(sS + (pt * 16 + fr) * 136 + kk * 32 + fq * 8);
          acc[pt] = __builtin_amdgcn_mfma_f32_16x16x32_bf16(sf, cf[kk], acc[pt], 0, 0, 0);
        }
      const float ea = expf(sAcs[l]);
#pragma unroll
      for (int pt = 0; pt < 4; ++pt) { acc[pt].x *= ea; acc[pt].y *= ea; acc[pt].z *= ea; acc[pt].w *= ea; }
#pragma unroll
      for (int kk = 0; kk < 2; ++kk) {
        const bf16x8 mf = *(const bf16x8*)(sM + l * 72 + kk * 32 + fq * 8);
#pragma unroll
        for (int pt = 0; pt < 4; ++pt) {
          const bf16x8 xf = *(const bf16x8*)(sX + (pt * 16 + fr) * 72 + kk * 32 + fq * 8);
          acc[pt] = __builtin_amdgcn_mfma_f32_16x16x32_bf16(xf, mf, acc[pt], 0, 0, 0);
        }
      }
#pragma unroll
      for (int pt = 0; pt < 4; ++pt) {
        const int c = h * 64 + pt * 16 + fq * 4;
        const float x[4] = {lo2f(ex[pt].x), hi2f(ex[pt].x), lo2f(ex[pt].y), hi2f(ex[pt].y)};
        const float z[4] = {lo2f(ez[pt].x), hi2f(ez[pt].x), lo2f(ez[pt].y), hi2f(ez[pt].y)};
        const float y0 = (acc[pt].x + Dh * x[0]) * silu_(z[0]);
        const float y1 = (acc[pt].y + Dh * x[1]) * silu_(z[1]);
        const float y2 = (acc[pt].z + Dh * x[2]) * silu_(z[2]);
        const float y3 = (acc[pt].w + Dh * x[3]) * silu_(z[3]);
        ss += y0 * y0 + y1 * y1 + y2 * y2 + y3 * y3;
        st4bf(MIX + (row0 + l) * 1024 + 512 + c, y0, y1, y2, y3);
      }
      hsync();
      cur = nxt;
    }
    ss += __shfl_xor(ss, 16); ss += __shfl_xor(ss, 32);
    const float rstd = rsqrtf(ss * (1.f / 256.f) + 1e-6f);
#pragma unroll 1
    for (int hh = 0; hh < 4; ++hh)
#pragma unroll
      for (int pt = 0; pt < 4; ++pt) {
        const int c = (gi * 4 + hh) * 64 + pt * 16 + fq * 4;
        const float* nw = p.in[I_M2_NORMW] + c;
        float yv[4];
        ld4bf(MIX + (row0 + l) * 1024 + 512 + c, yv);
        st4bf(MIX + (row0 + l) * 1024 + 512 + c, yv[0] * rstd * nw[0], yv[1] * rstd * nw[1], yv[2] * rstd * nw[2], yv[3] * rstd * nw[3]);
      }
  }
}

#define RW_FRAG(T, row, kk) (*(const bf16x8*)((T) + (row) * 72 + (kk) * 32 + fq * 8))
#define RW_MMA(acc, nf, mf) acc = __builtin_amdgcn_mfma_f32_16x16x32_bf16(nf, mf, acc, 0, 0, 0)
DEVINL void phase_rwkv_chunk_a(const Params& p, int bid, int nb, char* smem) {
  const int tid = my_tid(), lane = tid & 63, wid = tid >> 6, fr = lane & 15, fq = lane >> 4;
  bf16_t* R0 = (bf16_t*)smem;
  bf16_t* R1 = R0 + 64 * 72;
  bf16_t* R2 = R1 + 64 * 72;
  bf16_t* R3 = R2 + 64 * 72;
  bf16_t* R4 = R3 + 64 * 72;
  bf16_t* R6 = R4 + 2 * 64 * 72;
  float* sL = (float*)R4;
  int* sQ = (int*)(smem + 65536 + 64 + 176);
  const bf16_t* PR = (const bf16_t*)(p.ws + OFF_PROJR);
  bf16_t* KK = (bf16_t*)(p.ws + OFF_RKK);
  bf16_t* RA = (bf16_t*)(p.ws + OFF_RA);
  bf16_t* WE = (bf16_t*)(p.ws + OFF_RWE);
  const bf16_t* KP = (const bf16_t*)(p.ws + OFF_RKP);
  bf16_t* MIX = (bf16_t*)(p.ws + OFF_MIX);
  float* LAM = (float*)(p.ws + OFF_LAM);
  const float* mu = p.in[I_RW_MU];
  unsigned* q = (unsigned*)(p.ws + OFF_CTL) + CTL_RWAQ;
  const int et = tid >> 2, ec = (tid & 3) * 16;
  for (;;) {
    hsync();
    if (tid == 0) sQ[0] = (int)atomicAdd(q, 1u);
    hsync();
    const int task = sQ[0];
    if (task >= 4096) break;
    const int c = task & 63, h = (task >> 6) & 7, b = task >> 9;
    const size_t row0 = (size_t)b * SEQ + c * 64;
    const size_t row = row0 + et;
    const int col = h * 64 + ec;
    {
      float wev[16];
      ld8bf(WE + row * 512 + col, wev); ld8bf(WE + row * 512 + col + 8, wev + 8);
#pragma unroll
      for (int j = 0; j < 16; j += 4) *(f32x4*)&sL[et * 64 + ec + j] = (f32x4){wev[j], wev[j + 1], wev[j + 2], wev[j + 3]};
    }
    hsync();
    {
      const int ch = tid & 63, seg = tid >> 6;
      float accs = 0.f;
#pragma unroll
      for (int i = 0; i < 16; ++i) { accs += sL[(seg * 16 + i) * 64 + ch]; sL[(seg * 16 + i) * 64 + ch] = accs; }
      hsync();
      float off = 0.f;
      for (int sg = 0; sg < seg; ++sg) off += sL[(sg * 16 + 15) * 64 + ch];
      hsync();
#pragma unroll
      for (int i = 0; i < 16; ++i) sL[(seg * 16 + i) * 64 + ch] += off;
    }
    hsync();
    u32x4 bhp[2], khp[2];
#pragma unroll
    for (int g8 = 0; g8 < 2; ++g8) {
      const int cc = ec + g8 * 8, cg = col + g8 * 8;
      float kkv[8], av[8], kpv[8], rv[8], vv[8];
      ld8bf(KK + row * 512 + cg, kkv);
      ld8bf(RA + row * 512 + cg, av);
      ld8bf(KP + row * 512 + cg, kpv);
      {
        float rc[8], rp[8], vc[8], vp[8];
        ld8bf(PR + row * 1792 + cg, rc);
        ld8bf(PR + row * 1792 + 1024 + cg, vc);
        if (c * 64 + et > 0) { ld8bf(PR + (row - 1) * 1792 + cg, rp); ld8bf(PR + (row - 1) * 1792 + 1024 + cg, vp); }
        else {
#pragma unroll
          for (int j = 0; j < 8; ++j) { rp[j] = 0.f; vp[j] = 0.f; }
        }
#pragma unroll
        for (int j = 0; j < 8; ++j) { rv[j] = rc[j] + (rp[j] - rc[j]) * mu[cg + j]; vv[j] = vc[j] + (vp[j] - vc[j]) * mu[1024 + cg + j]; }
      }
      float ab[8], rb[8], bt[8], kt[8], bh[8], kh[8];
#pragma unroll
      for (int j = 0; j < 8; ++j) {
        const float lt = -sL[et * 64 + cc + j], lp = (et > 0) ? -sL[(et - 1) * 64 + cc + j] : 0.f, l63 = -sL[63 * 64 + cc + j];
        const float beta = kkv[j] * av[j], em = __expf(-lt), e63 = __expf(l63 - lt);
        ab[j] = -kkv[j] * __expf(lp); rb[j] = rv[j] * __expf(lt);
        bt[j] = beta * em; kt[j] = kpv[j] * em; bh[j] = beta * e63; kh[j] = kpv[j] * e63;
        if (et == 63) LAM[(size_t)task * 64 + cc + j] = __expf(l63);
      }
      u32x4 o;
#define PK8(dst, a_) o.x = pk2(a_[0], a_[1]); o.y = pk2(a_[2], a_[3]); o.z = pk2(a_[4], a_[5]); o.w = pk2(a_[6], a_[7]); dst = o
      PK8(*(u32x4*)(R0 + et * 72 + cc), ab);
      PK8(*(u32x4*)(R1 + et * 72 + cc), rb);
      PK8(*(u32x4*)(R2 + et * 72 + cc), bt);
      PK8(*(u32x4*)(R3 + et * 72 + cc), kt);
      PK8(bhp[g8], bh);
      PK8(khp[g8], kh);
#undef PK8
#pragma unroll
      for (int j = 0; j < 8; ++j) R6[(cc + j) * 72 + et] = f2bf(vv[j]);
      __builtin_amdgcn_sched_barrier(0);
    }
    hsync();
    f32x4 mab[4], mak[4], mrb[4], mrk[4];
#pragma unroll
    for (int n = 0; n < 4; ++n) { mab[n] = (f32x4){0.f, 0.f, 0.f, 0.f}; mak[n] = mab[n]; mrb[n] = mab[n]; mrk[n] = mab[n]; }
#pragma unroll
    for (int kk = 0; kk < 2; ++kk) {
      const bf16x8 fa = RW_FRAG(R0, wid * 16 + fr, kk), frb = RW_FRAG(R1, wid * 16 + fr, kk);
#pragma unroll
      for (int n = 0; n < 4; ++n) {
        const bf16x8 fb = RW_FRAG(R2, n * 16 + fr, kk), fk = RW_FRAG(R3, n * 16 + fr, kk);
        RW_MMA(mab[n], fb, fa); RW_MMA(mak[n], fk, fa); RW_MMA(mrb[n], fb, frb); RW_MMA(mrk[n], fk, frb);
      }
    }
    {
      const int t = wid * 16 + fr;
#pragma unroll
      for (int n = 0; n < 4; ++n)
#pragma unroll
        for (int j = 0; j < 4; ++j) {
          const int s_ = n * 16 + fq * 4 + j;
          if (s_ >= t) { mab[n][j] = 0.f; mak[n][j] = 0.f; }
          if (s_ > t) { mrb[n][j] = 0.f; mrk[n][j] = 0.f; }
        }
    }
    u32x2 mrbp[4], mrkp[4];
#pragma unroll
    for (int n = 0; n < 4; ++n) {
      mrbp[n].x = pk2(mrb[n].x, mrb[n].y); mrbp[n].y = pk2(mrb[n].z, mrb[n].w);
      mrkp[n].x = pk2(mrk[n].x, mrk[n].y); mrkp[n].y = pk2(mrk[n].z, mrk[n].w);
    }
    u32x2 rbq[4];
#pragma unroll
    for (int n = 0; n < 4; ++n) rbq[n] = *(const u32x2*)(R1 + (wid * 16 + fr) * 72 + n * 16 + fq * 4);
    hsync();
    {
      const int t = wid * 16 + fr;
#pragma unroll
      for (int n = 0; n < 4; ++n) {
        st4bf(R4 + t * 72 + n * 16 + fq * 4, mab[n].x, mab[n].y, mab[n].z, mab[n].w);
        st4bf(R2 + t * 72 + n * 16 + fq * 4, mak[n].x, mak[n].y, mak[n].z, mak[n].w);
      }
    }
    hsync();
    {
      f32x4 r2[4];
#pragma unroll
      for (int n = 0; n < 4; ++n) r2[n] = (f32x4){0.f, 0.f, 0.f, 0.f};
#pragma unroll
      for (int kk = 0; kk < 2; ++kk) {
        const bf16x8 fm = RW_FRAG(R2, wid * 16 + fr, kk);
#pragma unroll
        for (int n = 0; n < 4; ++n) { const bf16x8 fv = RW_FRAG(R6, n * 16 + fr, kk); RW_MMA(r2[n], fv, fm); }
      }
#pragma unroll
      for (int n = 0; n < 4; ++n) st4bf(R3 + (wid * 16 + fr) * 72 + n * 16 + fq * 4, r2[n].x, r2[n].y, r2[n].z, r2[n].w);
    }
    hsync();
    {
      float* sBB = (float*)(R4 + 64 * 72);
      const bf16_t* src = (tid < 64) ? (R0 + tid) : (R3 + ((tid - 64) & 63));
      bf16_t* dst = (tid < 64) ? (R2 + tid * 72) : (R1 + ((tid - 64) & 63) * 72);
      if (tid < 128) {
#pragma unroll
        for (int t = 0; t < 64; t += 8) *(u32x4*)(dst + t) = (u32x4){0u, 0u, 0u, 0u};
      }
      hsync();
#pragma unroll 1
      for (int ib = 0; ib < 4; ++ib) {
        if (ib > 0) {
          const bf16_t* XT = (wid < 2) ? (R2 + (32 * wid) * 72) : (R1 + (32 * (wid - 2)) * 72);
          f32x4 o2[2];
          o2[0] = (f32x4){0.f, 0.f, 0.f, 0.f}; o2[1] = o2[0];
#pragma unroll
          for (int kk = 0; kk < 2; ++kk) {
            const bf16x8 fm = RW_FRAG(R4, ib * 16 + fr, kk);
#pragma unroll
            for (int n2 = 0; n2 < 2; ++n2) { const bf16x8 fx = RW_FRAG(XT, n2 * 16 + fr, kk); RW_MMA(o2[n2], fx, fm); }
          }
#pragma unroll
          for (int n2 = 0; n2 < 2; ++n2) *(f32x4*)&sBB[fr * 128 + 32 * wid + n2 * 16 + fq * 4] = o2[n2];
          hsync();
        }
        if (tid < 128) {
          float xl[16];
#pragma unroll
          for (int tt = 0; tt < 16; ++tt) {
            const int t = ib * 16 + tt;
            float acc = bf2f(src[t * 72]);
            if (ib > 0) acc += sBB[tt * 128 + tid];
            if (tt > 0) {
              float m[16];
              ld8bf(R4 + t * 72 + ib * 16, m); ld8bf(R4 + t * 72 + ib * 16 + 8, m + 8);
#pragma unroll
              for (int ss = 0; ss < tt; ++ss) acc += m[ss] * xl[ss];
            }
            xl[tt] = bf2f(f2bf(acc));
          }
          u32x4 o;
          o.x = pk2(xl[0], xl[1]); o.y = pk2(xl[2], xl[3]); o.z = pk2(xl[4], xl[5]); o.w = pk2(xl[6], xl[7]);
          *(u32x4*)(dst + ib * 16) = o;
          o.x = pk2(xl[8], xl[9]); o.y = pk2(xl[10], xl[11]); o.z = pk2(xl[12], xl[13]); o.w = pk2(xl[14], xl[15]);
          *(u32x4*)(dst + ib * 16 + 8) = o;
        }
        hsync();
      }
    }
    {
      const int t = wid * 16 + fr;
#pragma unroll
      for (int n = 0; n < 4; ++n) {
        *(u32x2*)(R0 + t * 72 + n * 16 + fq * 4) = mrbp[n];
        *(u32x2*)(R3 + t * 72 + n * 16 + fq * 4) = mrkp[n];
      }
      bf16_t* R5 = R4 + 64 * 72;
      const unsigned b4[8] = {bhp[0].x, bhp[0].y, bhp[0].z, bhp[0].w, bhp[1].x, bhp[1].y, bhp[1].z, bhp[1].w};
      const unsigned k4[8] = {khp[0].x, khp[0].y, khp[0].z, khp[0].w, khp[1].x, khp[1].y, khp[1].z, khp[1].w};
#pragma unroll
      for (int j = 0; j < 8; ++j) {
        R4[(ec + 2 * j) * 72 + et] = (bf16_t)(b4[j] & 0xffffu); R4[(ec + 2 * j + 1) * 72 + et] = (bf16_t)(b4[j] >> 16);
        R5[(ec + 2 * j) * 72 + et] = (bf16_t)(k4[j] & 0xffffu); R5[(ec + 2 * j + 1) * 72 + et] = (bf16_t)(k4[j] >> 16);
      }
    }
    hsync();
    {
      const bf16_t* R5 = R4 + 64 * 72;
      const int rr = wid * 16 + fr;
#define RW_PROD(acc, MT1, NT1, HAS2, MT2, NT2) do { \
        _Pragma("unroll") for (int n = 0; n < 4; ++n) acc[n] = (f32x4){0.f, 0.f, 0.f, 0.f}; \
        _Pragma("unroll") for (int kk = 0; kk < 2; ++kk) { \
          const bf16x8 _m1 = RW_FRAG(MT1, rr, kk); \
          _Pragma("unroll") for (int n = 0; n < 4; ++n) { const bf16x8 _n1 = RW_FRAG(NT1, n * 16 + fr, kk); RW_MMA(acc[n], _n1, _m1); } \
          if (HAS2) { const bf16x8 _m2 = RW_FRAG(MT2, rr, kk); \
            _Pragma("unroll") for (int n = 0; n < 4; ++n) { const bf16x8 _n2 = RW_FRAG(NT2, n * 16 + fr, kk); RW_MMA(acc[n], _n2, _m2); } } \
        } } while (0)
      f32x4 o4[4];
      RW_PROD(o4, R0, R2, false, R0, R2);
#pragma unroll
      for (int n = 0; n < 4; ++n)
        st4bf(KK + (row0 + rr) * 512 + h * 64 + n * 16 + fq * 4, o4[n].x + lo2f(rbq[n].x), o4[n].y + hi2f(rbq[n].x), o4[n].z + lo2f(rbq[n].y), o4[n].w + hi2f(rbq[n].y));
      __builtin_amdgcn_sched_barrier(0);
      RW_PROD(o4, R0, R1, true, R3, R6);
#pragma unroll
      for (int n = 0; n < 4; ++n) st4bf(RA + (row0 + rr) * 512 + h * 64 + n * 16 + fq * 4, o4[n].x, o4[n].y, o4[n].z, o4[n].w);
      __builtin_amdgcn_sched_barrier(0);
      RW_PROD(o4, R4, R2, false, R4, R2);
#pragma unroll
      for (int n = 0; n < 4; ++n) st4bf(WE + (row0 + rr) * 512 + h * 64 + n * 16 + fq * 4, o4[n].x, o4[n].y, o4[n].z, o4[n].w);
      __builtin_amdgcn_sched_barrier(0);
      RW_PROD(o4, R1, R4, true, R6, R5);
#pragma unroll
      for (int n = 0; n < 4; ++n) st4bf(MIX + (row0 + rr) * 1024 + h * 64 + n * 16 + fq * 4, o4[n].x, o4[n].y, o4[n].z, o4[n].w);
#undef RW_PROD
    }
  }
}
DEVINL void phase_rwkv_chunk_b(const Params& p, int bid, int nb, char* smem) {
  const int tid = my_tid(), lane = tid & 63, wid = tid >> 6, fr = lane & 15, fq = lane >> 4;
  bf16_t* sS0 = (bf16_t*)smem;
  const bf16_t* Q1 = (const bf16_t*)(p.ws + OFF_RKK);
  bf16_t* Q2 = (bf16_t*)(p.ws + OFF_RA);
  const bf16_t* G1T = (const bf16_t*)(p.ws + OFF_RWE);
  const bf16_t* MIX = (const bf16_t*)(p.ws + OFF_MIX);
  const float* LAM = (const float*)(p.ws + OFF_LAM);
  struct Ops { bf16x8 q1f[2]; bf16x8 g1f[2]; u32x2 q2v, g2v; f32x4 lam; };
  for (int item = bid; item < 256; item += nb) {
    const int vq = item & 3, h = (item >> 2) & 7, b = item >> 5;
    auto load_ops = [&](Ops& o, int c) {
      const size_t row0 = (size_t)b * SEQ + c * 64;
      const int task = (b * 8 + h) * 64 + c;
#pragma unroll
      for (int kk = 0; kk < 2; ++kk) {
        o.q1f[kk] = *(const bf16x8*)(Q1 + (row0 + wid * 16 + fr) * 512 + h * 64 + kk * 32 + fq * 8);
        o.g1f[kk] = *(const bf16x8*)(G1T + (row0 + wid * 16 + fr) * 512 + h * 64 + kk * 32 + fq * 8);
      }
      o.q2v = *(const u32x2*)(Q2 + (row0 + wid * 16 + fr) * 512 + h * 64 + vq * 16 + fq * 4);
      o.g2v = *(const u32x2*)(MIX + (row0 + vq * 16 + fr) * 1024 + h * 64 + wid * 16 + fq * 4);
      o.lam = *(const f32x4*)(LAM + (size_t)task * 64 + wid * 16 + fq * 4);
    };
    f32x4 S = (f32x4){0.f, 0.f, 0.f, 0.f};
    auto step = [&](const Ops& o, int c) {
      const size_t row0 = (size_t)b * SEQ + c * 64;
      bf16_t* sS = sS0 + (c & 1) * (16 * 72);
      st4bf(sS + fr * 72 + wid * 16 + fq * 4, S.x, S.y, S.z, S.w);
      hsync();
      f32x4 y = (f32x4){0.f, 0.f, 0.f, 0.f}, sn = y;
#pragma unroll
      for (int kk = 0; kk < 2; ++kk) {
        const bf16x8 fs = RW_FRAG(sS, fr, kk);
        RW_MMA(sn, o.g1f[kk], fs);
        RW_MMA(y, fs, o.q1f[kk]);
      }
      S.x = S.x * o.lam.x + sn.x + lo2f(o.g2v.x); S.y = S.y * o.lam.y + sn.y + hi2f(o.g2v.x);
      S.z = S.z * o.lam.z + sn.z + lo2f(o.g2v.y); S.w = S.w * o.lam.w + sn.w + hi2f(o.g2v.y);
      st4bf(Q2 + (row0 + wid * 16 + fr) * 512 + h * 64 + vq * 16 + fq * 4, y.x + lo2f(o.q2v.x), y.y + hi2f(o.q2v.x), y.z + lo2f(o.q2v.y), y.w + hi2f(o.q2v.y));
    };
    hsync();
    Ops o0, o1, o2, o3;
    load_ops(o0, 0); load_ops(o1, 1); load_ops(o2, 2);
#pragma unroll 1
    for (int c = 0; c < 64; c += 4) {
      load_ops(o3, c + 3);
      step(o0, c);
      if (c + 4 < 64) load_ops(o0, c + 4);
      step(o1, c + 1);
      if (c + 5 < 64) load_ops(o1, c + 5);
      step(o2, c + 2);
      if (c + 6 < 64) load_ops(o2, c + 6);
      step(o3, c + 3);
    }
  }
}

namespace g8 {
#define G8_LAS __attribute__((address_space(3)))
constexpr int BM = 256, BK = 64, HALFR = 128, HTB = HALFR * BK * 2, STAGE_BYTES = 8 * HTB, NXCD = 8, WGM = 8;
DEVINL int lds_byte(int r, int c) { const int st = (r >> 4) * 2 + (c >> 5), rr = r & 15, cc = c & 31, ob = rr * 64 + cc * 2; return st * 1024 + (ob ^ (((ob >> 9) & 1) << 5)); }
DEVINL void stage_rc(int b, int& R, int& C) { const int st = b / 1024, sb = b % 1024, swz = sb ^ (((sb >> 9) & 1) << 5); R = (st >> 1) * 16 + swz / 64; C = (st & 1) * 32 + (swz % 64) / 2; }
struct Order {
  int nM, nN, nwg, G, c;
  DEVINL void init(int nM_, int nN_, int G_, int c_) { nM = nM_; nN = nN_; nwg = nM * nN; G = G_; c = c_; }
  DEVINL bool next(int i, int& pm, int& pn) const {
    const long L = (long)i * G + c; if (L >= nwg) return false;
    int wgid = (int)L; { const int q = nwg / NXCD, r = nwg % NXCD, xcd = wgid % NXCD, off = wgid / NXCD; wgid = (xcd < r ? xcd * (q + 1) : r * (q + 1) + (xcd - r) * q) + off; }
    const int nig = WGM * nN, gid = wgid / nig, fm = gid * WGM, gsz = (nM - fm) < WGM ? (nM - fm) : WGM;
    pm = fm + ((wgid % nig) % gsz); pn = (wgid % nig) / gsz; return true;
  }
};
template <class Job>
DEVINL void gemm8(const Job& J) {
  G8_LAS unsigned char* lds = (G8_LAS unsigned char*)g_smem;
  const int tid = threadIdx.x, wid = __builtin_amdgcn_readfirstlane(tid >> 6), lane = tid & 63, wr = wid >> 2, wc = wid & 3, fr = lane & 15, fq = lane >> 4;
  const int K = Job::K, nt = K / BK;
  int Rp[2], Cp[2];
  unsigned voffB[2];
#pragma unroll
  for (int i = 0; i < 2; ++i) { stage_rc(tid * 16 + i * 8192, Rp[i], Cp[i]); voffB[i] = (unsigned)(Rp[i] * K + Cp[i]) * 2u; }
  const size_t kstep = (size_t)(BK * 2);
  const size_t hstepB = (size_t)HALFR * K * 2;
  const unsigned ldsw = (unsigned)wid * 1024u;
  const int aoff = lds_byte(wr * 64 + fr, fq * 8), boff = lds_byte(wc * 32 + fr, fq * 8);
#define G8_SA(b, h) (((b) * 2 + (h)) * HTB)
#define G8_SB(b, h) ((4 + (b) * 2 + (h)) * HTB)
#define G8_STAGE(bufoff, gbase, voff) do { _Pragma("unroll") for (int _i = 0; _i < 2; ++_i) \
    __builtin_amdgcn_global_load_lds((const unsigned*)((const char*)(gbase) + (voff)[_i]), (G8_LAS unsigned*)(lds + (bufoff) + ldsw + _i * 8192), 16, 0, 0); } while (0)
#define G8_LDA(dst, b, h) do { _Pragma("unroll") for (int m = 0; m < 4; ++m) _Pragma("unroll") for (int k = 0; k < 2; ++k) dst[m][k] = *(const G8_LAS bf16x8*)(lds + G8_SA(b, h) + aoff + m * 2048 + k * 1024); } while (0)
#define G8_LDB(dst, b, h) do { _Pragma("unroll") for (int n = 0; n < 2; ++n) _Pragma("unroll") for (int k = 0; k < 2; ++k) dst[n][k] = *(const G8_LAS bf16x8*)(lds + G8_SB(b, h) + boff + n * 2048 + k * 1024); } while (0)
#define G8_MMA(ai, bj, At, Bt) do { __builtin_amdgcn_s_setprio(1); _Pragma("unroll") for (int m = 0; m < 4; ++m) _Pragma("unroll") for (int n = 0; n < 2; ++n) _Pragma("unroll") for (int k = 0; k < 2; ++k) \
    acc[ai][bj][m][n] = __builtin_amdgcn_mfma_f32_16x16x32_bf16(Bt[n][k], At[m][k], acc[ai][bj][m][n], 0, 0, 0); __builtin_amdgcn_s_setprio(0); } while (0)
#define G8_WAIT_V(n) asm volatile("s_waitcnt vmcnt(" #n ")" ::: "memory")
#define G8_WAIT_L(n) asm volatile("s_waitcnt lgkmcnt(" #n ")" ::: "memory")
#define G8_BAR __builtin_amdgcn_s_barrier()
#define G8_SCHED __builtin_amdgcn_sched_barrier(0)
  Order S; S.init(J.nM(), J.nN(), gridDim.x, blockIdx.x);
  int cpm, cpn, npm = 0, npn = 0, ui = 0;
  if (!S.next(0, cpm, cpn)) return;
  f32x4 acc[2][2][4][2];
#pragma unroll
  for (int a = 0; a < 2; ++a)
#pragma unroll
    for (int b = 0; b < 2; ++b)
#pragma unroll
      for (int m = 0; m < 4; ++m)
#pragma unroll
        for (int n = 0; n < 2; ++n) acc[a][b][m][n] = (f32x4){0.f, 0.f, 0.f, 0.f};
  bf16x8 At[4][2], B0[2][2], B1[2][2];
  const char* cA = J.a_base(cpm); const char* cB = J.b_base(cpm, cpn);
  unsigned cv0[2], cv1[2];
  { unsigned v[2][2]; J.a_voff(cpm, Rp, Cp, v); cv0[0] = v[0][0]; cv0[1] = v[0][1]; cv1[0] = v[1][0]; cv1[1] = v[1][1]; }
  G8_STAGE(G8_SB(0, 0), cB, voffB); G8_STAGE(G8_SA(0, 0), cA, cv0); G8_STAGE(G8_SB(0, 1), cB + hstepB, voffB); G8_STAGE(G8_SA(0, 1), cA, cv1);
  if (wr == 1) G8_BAR;
  G8_WAIT_V(4); G8_BAR;
  G8_STAGE(G8_SB(1, 0), cB + kstep, voffB); G8_STAGE(G8_SA(1, 0), cA + kstep, cv0); G8_STAGE(G8_SB(1, 1), cB + hstepB + kstep, voffB);
  G8_WAIT_V(6); G8_BAR;
  for (;;) {
    const bool has_next = S.next(ui + 1, npm, npn);
    const char* nA = has_next ? J.a_base(npm) : cA; const char* nB = has_next ? J.b_base(npm, npn) : cB;
    unsigned nv0[2] = {cv0[0], cv0[1]}, nv1[2] = {cv1[0], cv1[1]};
    if (has_next) { unsigned v[2][2]; J.a_voff(npm, Rp, Cp, v); nv0[0] = v[0][0]; nv0[1] = v[0][1]; nv1[0] = v[1][0]; nv1[1] = v[1][1]; }
    for (int t = 0; t < nt; t += 2) {
      const bool last = (t == nt - 2);
      const char* a1 = cA + (size_t)(t + 1) * kstep;
      const char* a2 = last ? nA : cA + (size_t)(t + 2) * kstep; const char* b2 = last ? nB : cB + (size_t)(t + 2) * kstep;
      const char* a3 = a2 + kstep; const char* b3 = b2 + kstep;
      const unsigned x0[2] = {last ? nv0[0] : cv0[0], last ? nv0[1] : cv0[1]}, x1[2] = {last ? nv1[0] : cv1[0], last ? nv1[1] : cv1[1]};
      G8_LDB(B0, 0, 0); G8_SCHED; G8_LDA(At, 0, 0); G8_STAGE(G8_SA(1, 1), a1, cv1);
      G8_WAIT_L(8); G8_BAR; G8_WAIT_L(0); G8_MMA(0, 0, At, B0); G8_BAR; G8_SCHED;
      G8_LDB(B1, 0, 1); G8_STAGE(G8_SB(0, 0), b2, voffB);
      G8_BAR; G8_WAIT_L(0); G8_MMA(0, 1, At, B1); G8_BAR;
      G8_LDA(At, 0, 1); G8_STAGE(G8_SA(0, 0), a2, x0);
      G8_BAR; G8_WAIT_L(0); G8_MMA(1, 0, At, B0); G8_BAR; G8_SCHED;
      G8_STAGE(G8_SB(0, 1), b2 + hstepB, voffB);
      G8_WAIT_V(6); G8_BAR; G8_MMA(1, 1, At, B1); G8_BAR;
      G8_LDB(B0, 1, 0); G8_SCHED; G8_LDA(At, 1, 0); G8_STAGE(G8_SA(0, 1), a2, x1);
      G8_WAIT_L(8); G8_BAR; G8_WAIT_L(0); G8_MMA(0, 0, At, B0); G8_BAR; G8_SCHED;
      G8_LDB(B1, 1, 1); G8_STAGE(G8_SB(1, 0), b3, voffB);
      G8_BAR; G8_WAIT_L(0); G8_MMA(0, 1, At, B1); G8_BAR;
      G8_LDA(At, 1, 1); G8_STAGE(G8_SA(1, 0), a3, x0);
      G8_BAR; G8_WAIT_L(0); G8_MMA(1, 0, At, B0); G8_BAR; G8_SCHED;
      G8_STAGE(G8_SB(1, 1), b3 + hstepB, voffB);
      G8_WAIT_V(6); G8_BAR; G8_MMA(1, 1, At, B1); G8_BAR;
    }
    J.epi(acc, cpm, cpn, wr, wc, fr, fq);
    if (!has_next) break;
#pragma unroll
    for (int a = 0; a < 2; ++a)
#pragma unroll
      for (int b = 0; b < 2; ++b)
#pragma unroll
        for (int m = 0; m < 4; ++m)
#pragma unroll
          for (int n = 0; n < 2; ++n) acc[a][b][m][n] = (f32x4){0.f, 0.f, 0.f, 0.f};
    cpm = npm; cpn = npn; cA = nA; cB = nB; cv0[0] = nv0[0]; cv0[1] = nv0[1]; cv1[0] = nv1[0]; cv1[1] = nv1[1]; ++ui;
  }
  G8_WAIT_V(0);
  if (wr == 0) G8_BAR;
  G8_BAR;
#undef G8_SA
#undef G8_SB
#undef G8_STAGE
#undef G8_LDA
#undef G8_LDB
#undef G8_MMA
#undef G8_WAIT_V
#undef G8_WAIT_L
#undef G8_BAR
#undef G8_SCHED
}
typedef f32x4 Acc8[2][2][4][2];
#define G8_EPI_LOOP _Pragma("unroll") for (int ai = 0; ai < 2; ++ai) _Pragma("unroll") for (int m = 0; m < 4; ++m) _Pragma("unroll") for (int bj = 0; bj < 2; ++bj) _Pragma("unroll") for (int n = 0; n < 2; ++n)
#define G8_ROW (256 * pm + 128 * ai + 64 * wr + 16 * m + fr)
#define G8_COL (256 * pn + 128 * bj + 32 * wc + 16 * n + 4 * fq)
template <int LDA> DEVINL void a_voff_regular(const int (&R)[2], const int (&C)[2], unsigned (&v)[2][2]) {
#pragma unroll
  for (int h = 0; h < 2; ++h)
#pragma unroll
    for (int i = 0; i < 2; ++i) v[h][i] = (unsigned)((h * 128 + R[i]) * LDA + C[i]) * 2u;
}
struct JobIn0 {
  static constexpr int K = 1024;
  const bf16_t* A; const bf16_t* B; bf16_t* C;
  DEVINL int nM() const { return T / 256; } DEVINL int nN() const { return 8; }
  DEVINL const char* a_base(int pm) const { return (const char*)(A + (size_t)pm * 256 * 1024); }
  DEVINL void a_voff(int, const int (&R)[2], const int (&Cc)[2], unsigned (&v)[2][2]) const { a_voff_regular<1024>(R, Cc, v); }
  DEVINL const char* b_base(int, int pn) const { return (const char*)(B + (size_t)pn * 256 * 1024); }
  DEVINL void epi(const Acc8& acc, int pm, int pn, int wr, int wc, int fr, int fq) const {
    G8_EPI_LOOP st4bf(C + (size_t)G8_ROW * 2048 + G8_COL, acc[ai][bj][m][n].x, acc[ai][bj][m][n].y, acc[ai][bj][m][n].z, acc[ai][bj][m][n].w);
  }
};
struct JobIn1 {
  static constexpr int K = 1024;
  const bf16_t* A; const bf16_t* B; bf16_t* CR; bf16_t* CM; float* DT;
  DEVINL int nM() const { return T / 256; } DEVINL int nN() const { return 14; }
  DEVINL const char* a_base(int pm) const { return (const char*)(A + (size_t)pm * 256 * 1024); }
  DEVINL void a_voff(int, const int (&R)[2], const int (&Cc)[2], unsigned (&v)[2][2]) const { a_voff_regular<1024>(R, Cc, v); }
  DEVINL const char* b_base(int, int pn) const { return (const char*)(B + (size_t)pn * 256 * 1024); }
  DEVINL void epi(const Acc8& acc, int pm, int pn, int wr, int wc, int fr, int fq) const {
    G8_EPI_LOOP {
      const int row = G8_ROW, col = G8_COL; const f32x4 a = acc[ai][bj][m][n];
      if (col < 1792) st4bf(CR + (size_t)row * 1792 + col, a.x, a.y, a.z, a.w);
      else if (col < 3456) {
        st4bf(CM + (size_t)row * 1664 + (col - 1792), a.x, a.y, a.z, a.w);
        if (col >= 3328 && col < 3336) *(f32x4*)(DT + (size_t)row * 8 + (col - 3328)) = a;
      }
    }
  }
};
struct JobGlu {
  static constexpr int K = 512;
  const bf16_t* A; const bf16_t* B; bf16_t* C;
  DEVINL int nM() const { return T / 256; } DEVINL int nN() const { return 4; }
  DEVINL const char* a_base(int pm) const { return (const char*)(A + (size_t)pm * 256 * 512); }
  DEVINL void a_voff(int, const int (&R)[2], const int (&Cc)[2], unsigned (&v)[2][2]) const { a_voff_regular<512>(R, Cc, v); }
  DEVINL const char* b_base(int, int pn) const { return (const char*)(B + (size_t)pn * 256 * 512); }
  DEVINL void epi(const Acc8& acc, int pm, int pn, int wr, int wc, int fr, int fq) const {
#pragma unroll
    for (int ai = 0; ai < 2; ++ai)
#pragma unroll
      for (int m = 0; m < 4; ++m)
#pragma unroll
        for (int bj = 0; bj < 2; ++bj) {
          const int row = 256 * pm + 128 * ai + 64 * wr + 16 * m + fr, hc = (256 * pn + 128 * bj + 32 * wc) / 2 + 4 * fq;
          const f32x4 a = acc[ai][bj][m][0], g = acc[ai][bj][m][1];
          st4bf(C + (size_t)row * 1024 + hc, a.x * sigmoid_(g.x), a.y * sigmoid_(g.y), a.z * sigmoid_(g.z), a.w * sigmoid_(g.w));
        }
  }
};
template <int LYR>
struct JobOut {
  static constexpr int K = 1024;
  const bf16_t* A; const bf16_t* B; const float* xin32; const bf16_t* xin16; bf16_t* xo; const float* gate1;
  DEVINL int nM() const { return T / 256; } DEVINL int nN() const { return 4; }
  DEVINL const char* a_base(int pm) const { return (const char*)(A + (size_t)pm * 256 * 1024); }
  DEVINL void a_voff(int, const int (&R)[2], const int (&Cc)[2], unsigned (&v)[2][2]) const { a_voff_regular<1024>(R, Cc, v); }
  DEVINL const char* b_base(int, int pn) const { return (const char*)(B + (size_t)pn * 256 * 1024); }
  DEVINL void epi(const Acc8& acc, int pm, int pn, int wr, int wc, int fr, int fq) const {
    const float* gt = gate1 + (size_t)((pm * 256) >> 12) * 6144;
    G8_EPI_LOOP {
      const int row = G8_ROW, col = G8_COL; const f32x4 a = acc[ai][bj][m][n];
      float x[4];
      if (LYR == 0) { const f32x4 t = *(const f32x4*)(xin32 + (size_t)row * 1024 + col); x[0] = t.x; x[1] = t.y; x[2] = t.z; x[3] = t.w; }
      else ld4bf(xin16 + (size_t)row * 1024 + col, x);
      const f32x4 g = *(const f32x4*)(gt + col);
      st4bf(xo + (size_t)row * 1024 + col, x[0] + g.x * a.x, x[1] + g.y * a.y, x[2] + g.z * a.z, x[3] + g.w * a.w);
    }
  }
};
DEVINL int moe_expert_of(const int* pst, int ti) { int e = 0; while (pst[e + 1] <= ti * 256) ++e; return e; }
struct JobMoeGu {
  static constexpr int K = 1024;
  const bf16_t* Hh; const bf16_t* W; const int* list; const int* cnt; const int* pst; bf16_t* ACT;
  DEVINL int nM() const { return pst[32] >> 8; } DEVINL int nN() const { return 4; }
  DEVINL const char* a_base(int) const { return (const char*)Hh; }
  DEVINL void a_voff(int pm, const int (&R)[2], const int (&Cc)[2], unsigned (&v)[2][2]) const {
    const int e = moe_expert_of(pst, pm), c_e = cnt[e * 32], pos0 = pm * 256 - pst[e];
#pragma unroll
    for (int h = 0; h < 2; ++h)
#pragma unroll
      for (int i = 0; i < 2; ++i) { const int pos = pos0 + h * 128 + R[i]; const int tk = (pos < c_e) ? list[(size_t)e * T + pos] : 0; v[h][i] = (unsigned)(tk * 1024 + Cc[i]) * 2u; }
  }
  DEVINL const char* b_base(int pm, int pn) const { return (const char*)(W + ((size_t)moe_expert_of(pst, pm) * 1024 + pn * 256) * 1024); }
  DEVINL void epi(const Acc8& acc, int pm, int pn, int wr, int wc, int fr, int fq) const {
#pragma unroll
    for (int ai = 0; ai < 2; ++ai)
#pragma unroll
      for (int m = 0; m < 4; ++m)
#pragma unroll
        for (int bj = 0; bj < 2; ++bj) {
          const int row = 256 * pm + 128 * ai + 64 * wr + 16 * m + fr, hc = (256 * pn + 128 * bj + 32 * wc) / 2 + 4 * fq;
          const f32x4 g = acc[ai][bj][m][0], u = acc[ai][bj][m][1];
          st4bf(ACT + (size_t)row * 512 + hc, silu_(g.x) * u.x, silu_(g.y) * u.y, silu_(g.z) * u.z, silu_(g.w) * u.w);
        }
  }
};
struct JobMoeDown {
  static constexpr int K = 512;
  const bf16_t* A; const bf16_t* W; const int* pst; bf16_t* Y;
  DEVINL int nM() const { return pst[32] >> 8; } DEVINL int nN() const { return 4; }
  DEVINL const char* a_base(int pm) const { return (const char*)(A + (size_t)pm * 256 * 512); }
  DEVINL void a_voff(int, const int (&R)[2], const int (&Cc)[2], unsigned (&v)[2][2]) const { a_voff_regular<512>(R, Cc, v); }
  DEVINL const char* b_base(int pm, int pn) const { return (const char*)(W + ((size_t)moe_expert_of(pst, pm) * 1024 + pn * 256) * 512); }
  DEVINL void epi(const Acc8& acc, int pm, int pn, int wr, int wc, int fr, int fq) const {
    G8_EPI_LOOP st4bf(Y + (size_t)G8_ROW * 1024 + G8_COL, acc[ai][bj][m][n].x, acc[ai][bj][m][n].y, acc[ai][bj][m][n].z, acc[ai][bj][m][n].w);
  }
};
}
DEVINL void phase8_inproj0(const Params& p) { g8::JobIn0 J{(const bf16_t*)(p.ws + OFF_H), (const bf16_t*)(p.ws + OFF_WIN0), (bf16_t*)(p.ws + OFF_PROJ0)}; g8::gemm8(J); }
DEVINL void phase8_inproj1(const Params& p) { g8::JobIn1 J{(const bf16_t*)(p.ws + OFF_H), (const bf16_t*)(p.ws + OFF_WIN1), (bf16_t*)(p.ws + OFF_PROJR), (bf16_t*)(p.ws + OFF_PROJM), (float*)(p.ws + OFF_DTRAW)}; g8::gemm8(J); }
DEVINL void phase8_glu(const Params& p) { g8::JobGlu J{(const bf16_t*)(p.ws + OFF_YS), (const bf16_t*)(p.ws + OFF_WGLU), (bf16_t*)(p.ws + OFF_MIX)}; g8::gemm8(J); }
DEVINL void phase8_outproj(const Params& p, int L) {
  const float* g1 = (const float*)(p.ws + OFF_MOD) + (size_t)L * 8 * 6144 + 2 * 1024;
  if (L == 0) { g8::JobOut<0> J{(const bf16_t*)(p.ws + OFF_MIX), (const bf16_t*)(p.ws + OFF_WOUT0), p.in[I_X], nullptr, (bf16_t*)p.out, g1}; g8::gemm8(J); }
  else { g8::JobOut<1> J{(const bf16_t*)(p.ws + OFF_MIX), (const bf16_t*)(p.ws + OFF_WOUT1), nullptr, (const bf16_t*)p.out, (bf16_t*)(p.ws + OFF_XR1), g1}; g8::gemm8(J); }
}
DEVINL int* moe_prefix8(const Params& p, int L) {
  int* pst = (int*)(g_smem + g8::STAGE_BYTES + 64);
  const int* ctl = (const int*)(p.ws + OFF_CTL);
  if (threadIdx.x == 0) {
    int sum = 0;
    for (int e = 0; e < 32; ++e) { pst[e] = sum; sum += ((ctl[CTL_COUNT + (L * 32 + e) * 32] + 255) >> 8) << 8; }
    pst[32] = sum;
  }
  __syncthreads();
  return pst;
}
DEVINL void phase8_moe_gu(const Params& p, int L) {
  const int* pst = moe_prefix8(p, L);
  g8::JobMoeGu J{(const bf16_t*)(p.ws + OFF_H), (const bf16_t*)(p.ws + OFF_WGU), (const int*)(p.ws + OFF_LIST), (const int*)(p.ws + OFF_CTL) + CTL_COUNT + L * 1024, pst, (bf16_t*)(p.ws + OFF_ACT)};
  g8::gemm8(J);
}
DEVINL void phase8_moe_down(const Params& p, int L) {
  const int* pst = moe_prefix8(p, L);
  g8::JobMoeDown J{(const bf16_t*)(p.ws + OFF_ACT), (const bf16_t*)(p.ws + OFF_WD), pst, (bf16_t*)(p.ws + OFF_YEXP)};
  g8::gemm8(J);
}

#define XB_TMO      128
#define XB_XCNT(j)  (256  + 64 * (j))
#define XB_XSUB(j)  (1280 + 64 * (j))
#define XB_XGEN(j)  (2304 + 64 * (j))
#define XB_TOP      3328
#define XB_TOPGEN   3392
#define XB_SPIN_CAP (1u << 22)
#define LAS __attribute__((address_space(3)))
DEVINL unsigned xb_ld(unsigned* p) { return __hip_atomic_load(p, __ATOMIC_RELAXED, __HIP_MEMORY_SCOPE_AGENT); }
DEVINL unsigned xb_add(unsigned* p, unsigned v) { return __hip_atomic_fetch_add(p, v, __ATOMIC_RELAXED, __HIP_MEMORY_SCOPE_AGENT); }
DEVINL unsigned xb_xcc_id() { return (unsigned)__builtin_amdgcn_s_getreg((3 << 11) | 20) & 0xFu; }
#define XB_SPIN(cond, bar) do { unsigned _sp = 0; while (cond) { __builtin_amdgcn_s_sleep(1); \
    if ((++_sp & 255u) == 0u) { if (xb_ld(&(bar)[XB_TMO])) break; if (_sp > XB_SPIN_CAP) { atomicAdd(&(bar)[XB_TMO], 1u); break; } } } } while (0)
struct XcdBarrier { unsigned* bar; unsigned x; volatile unsigned* st; };
DEVINL XcdBarrier xcd_barrier_post(unsigned* bar, volatile unsigned* st) {
  XcdBarrier b; b.bar = bar; b.x = xb_xcc_id(); b.st = st;
  if ((int)threadIdx.x == 0) (void)xb_add(&bar[XB_XCNT(b.x)], 1u);
  return b;
}
DEVINL void xcd_barrier_complete(unsigned* bar, unsigned x, unsigned& nloc, unsigned& nx) {
  const unsigned G = gridDim.x * gridDim.y * gridDim.z;
  unsigned sum, cnt, mine, sp = 0u;
  for (;;) {
    sum = 0u; cnt = 0u; mine = 0u;
#pragma unroll
    for (unsigned j = 0; j < 16; ++j) { const unsigned c = xb_ld(&bar[XB_XCNT(j)]); sum += c; cnt += (c > 0u) ? 1u : 0u; mine = (j == x) ? c : mine; }
    if (sum == G) break;
    __builtin_amdgcn_s_sleep(1);
    if ((++sp & 255u) == 0u) { if (xb_ld(&bar[XB_TMO])) break; if (sp > XB_SPIN_CAP) { atomicAdd(&bar[XB_TMO], 1u); break; } }
  }
  nloc = mine > 0u ? mine : 1u; nx = cnt > 0u ? cnt : 1u;
}
DEVINL void xcd_barrier(const XcdBarrier& b) {
  asm volatile("s_waitcnt vmcnt(0)" ::: "memory");
  __syncthreads();
  if ((int)threadIdx.x == 0) {
    unsigned* bar = b.bar;
    __builtin_amdgcn_s_waitcnt(0);
    unsigned nloc = b.st[0], nx = b.st[1];
    if (nloc == 0u) { xcd_barrier_complete(bar, b.x, nloc, nx); b.st[0] = nloc; b.st[1] = nx; }
    const unsigned old = xb_add(&bar[XB_XSUB(b.x)], 1u);
    const unsigned gen = old / nloc;
    if (old + 1u == (gen + 1u) * nloc) {
      __builtin_amdgcn_fence(__ATOMIC_RELEASE, "agent");
      asm volatile("s_waitcnt vmcnt(0)" ::: "memory");
      const unsigned og = xb_add(&bar[XB_TOP], 1u);
      const unsigned tg = og / nx;
      if (og + 1u == (tg + 1u) * nx) xb_add(&bar[XB_TOPGEN], 1u);
      else XB_SPIN(xb_ld(&bar[XB_TOPGEN]) == tg, bar);
      __builtin_amdgcn_fence(__ATOMIC_ACQUIRE, "agent");
      xb_add(&bar[XB_XGEN(b.x)], 1u);
      asm volatile("s_waitcnt vmcnt(0)" ::: "memory");
    } else {
      XB_SPIN(xb_ld(&bar[XB_XGEN(b.x)]) == gen, bar);
      __builtin_amdgcn_fence(__ATOMIC_ACQUIRE, "agent");
      asm volatile("s_waitcnt vmcnt(0)" ::: "memory");
    }
  }
  __syncthreads();
}

namespace cg = cooperative_groups;
#define GSYNC() xcd_barrier(xb)
__global__ void __launch_bounds__(512, 2) fwd_megakernel(Params p) {
  cg::grid_group grid = cg::this_grid();
  const int half = threadIdx.x >> 8;
  const int bid = half * gridDim.x + blockIdx.x, nb = gridDim.x * 2;
  char* smem = g_smem + half * HALF_LDS;
  volatile unsigned* xst = (volatile unsigned*)(g_smem + XST_OFF);
  if (threadIdx.x < 4) xst[threadIdx.x] = 0u;
  if (threadIdx.x == 8 || threadIdx.x == 9) *(volatile unsigned*)(g_smem + HS_OFF + (threadIdx.x - 8) * 64) = 0u;
  __syncthreads();
  XcdBarrier xb = xcd_barrier_post((unsigned*)(p.ws + OFF_CTL), xst);
  phase_prep(p, bid, nb, smem);
  grid.sync();
  phase_norm(p, bid, nb, 0, 0, smem);
  GSYNC();
  phase8_inproj0(p);
  GSYNC();
  if (bid < 128) phase_s5_a(p, bid, 128, smem);
  else phase_moe_convert(p, bid - 128, nb - 128, 0, smem, 0, 6144);
  GSYNC();
  if (bid < 64) phase_s5_scan(p, bid, 64, smem);
  else { phase_moe_convert(p, bid - 64, nb - 64, 0, smem, 6144, 12288); phase_prep_l1(p, bid - 64, nb - 64, smem); }
  GSYNC();
  phase_s5_b(p, bid, nb, smem);
  phase_attn(p, bid, nb, smem);
  GSYNC();
  phase8_glu(p);
  GSYNC();
  phase8_outproj(p, 0);
  GSYNC();
  phase_norm_router(p, bid, nb, 0, smem);
  GSYNC();
  phase8_moe_gu(p, 0);
  GSYNC();
  phase8_moe_down(p, 0);
  GSYNC();
  phase_norm(p, bid, nb, 2, 1, smem);
  GSYNC();
  phase8_inproj1(p);
  GSYNC();
  if (bid < nb / 2) phase_m2_pre(p, bid, nb / 2, smem);
  else phase_rwkv_pre(p, bid - nb / 2, nb - nb / 2, smem);
  GSYNC();
  if (bid < nb / 2) phase_ssd_a(p, bid, nb / 2, smem);
  else phase_rwkv_lora01(p, bid - nb / 2, nb - nb / 2);
  GSYNC();
  if (nb >= 256) { if (bid < 128) phase_ssd_b(p, bid, 128, smem); }
  else phase_ssd_b(p, bid, nb, smem);
  phase_rwkv_chunk_a(p, bid, nb, smem);
  GSYNC();
  if (nb >= 512) { if (bid < 256) { __builtin_amdgcn_s_setprio(3); phase_rwkv_chunk_b(p, bid, 256, smem); __builtin_amdgcn_s_setprio(0); } }
  else phase_rwkv_chunk_b(p, bid, nb, smem);
  phase_ssd_c(p, bid, nb, smem);
  GSYNC();
  phase_rwkv_lora(p, bid, nb, 2, smem);
  GSYNC();
  phase8_outproj(p, 1);
  __syncthreads();
  phase_moe_convert(p, bid, nb, 1, smem);
  GSYNC();
  phase_norm_router(p, bid, nb, 1, smem);
  GSYNC();
  phase8_moe_gu(p, 1);
  GSYNC();
  phase8_moe_down(p, 1);
  GSYNC();
  phase_norm(p, bid, nb, 3, 1, smem);
}

extern "C" void kernel_launch(void* const* d_in, const int* in_sizes, int n_in, void* d_out, int out_size, void* d_ws, size_t ws_size,
                              hipStream_t stream) {
  constexpr size_t kDynLds = LDS_TOTAL;
  static int grid_blocks = 0;
  if (n_in != N_IN || ws_size < WS_NEEDED) { fprintf(stderr, "kernel_launch: bad n_in %d or ws_size %zu (need %zu)\n", n_in, ws_size, (size_t)WS_NEEDED); return; }
  if (!grid_blocks) {
    int dev = 0, cus = 0, per_cu = 0;
    (void)hipGetDevice(&dev);
    (void)hipDeviceGetAttribute(&cus, hipDeviceAttributeMultiprocessorCount, dev);
    (void)hipFuncSetAttribute((const void*)fwd_megakernel, hipFuncAttributeMaxDynamicSharedMemorySize, (int)kDynLds);
    (void)hipOccupancyMaxActiveBlocksPerMultiprocessor(&per_cu, fwd_megakernel, 512, kDynLds);
    if (per_cu > 1) per_cu = 1;
    if (per_cu < 1) per_cu = 1;
    grid_blocks = cus * per_cu;
    fprintf(stderr, "kernel_launch: cus %d per_cu %d grid %d\n", cus, per_cu, grid_blocks);
  }
  Params p{};
  for (int i = 0; i < N_IN; ++i) p.in[i] = (const float*)d_in[i];
  p.out = (float*)d_out;
  p.ws = (char*)d_ws;
  (void)hipMemsetAsync((char*)d_ws + OFF_CTL, 0, 65536, stream);
  void* args[] = {&p};
  hipError_t e = hipLaunchCooperativeKernel((void*)fwd_megakernel, dim3(grid_blocks), dim3(512), args, kDynLds, stream);
  if (e != hipSuccess) fprintf(stderr, "cooperative launch failed: %s (grid %d)\n", hipGetErrorString(e), grid_blocks);
}
```

```cpp
#include <hip/hip_runtime.h>
#include <hip/hip_cooperative_groups.h>
#include <stdint.h>
#include <stdio.h>

typedef unsigned short bf16_t;
typedef __attribute__((ext_vector_type(8))) short bf16x8;
typedef __attribute__((ext_vector_type(4))) float f32x4;
typedef __attribute__((ext_vector_type(4))) unsigned u32x4;
typedef __attribute__((ext_vector_type(2))) unsigned u32x2;

#define DEVINL __device__ __forceinline__

constexpr int D = 1024, BATCH = 8, SEQ = 4096, T = BATCH * SEQ;
constexpr int NSLOT = 73728;

enum { I_X = 0, I_C, I_ADA_W, I_ADA_B, I_NORM_MIX, I_NORM_FFN, I_EVEN_WIN, I_EVEN_WOUT, I_S5_ARE, I_S5_AIM, I_S5_LOGDT,
       I_S5_BRE, I_S5_BIM, I_S5_CRE, I_S5_CIM, I_S5_D, I_S5_WGLU, I_ODD_WIN, I_ODD_WOUT, I_RW_MU, I_RW_W0, I_RW_W2,
       I_RW_A0, I_RW_A2, I_RW_G2, I_RW_KK, I_RW_KA, I_RW_RK, I_RW_LNW, I_RW_LNB, I_M2_CONVW, I_M2_CONVB, I_M2_DTB,
       I_M2_ALOG, I_M2_D, I_M2_NORMW, I_MOE_WGRP, I_MOE_BGRP, I_MOE_WEXP, I_MOE_BEXP, I_MOE_WGATE, I_MOE_WUP,
       I_MOE_WDOWN, I_FINAL_W, N_IN };

struct Params {
  const float* in[N_IN];
  float* out;
  char* ws;
};

constexpr size_t OFF_CTL    = 0;
constexpr size_t OFF_MOD    = 65536;
constexpr size_t OFF_WIN0   = OFF_MOD + 393216;
constexpr size_t OFF_WGLU   = OFF_WIN0 + 4194304;
constexpr size_t OFF_WOUT0  = OFF_WGLU + 1048576;
constexpr size_t OFF_WIN1   = OFF_WOUT0 + 2097152;
constexpr size_t OFF_WOUT1  = OFF_WIN1 + 7340032;
constexpr size_t OFF_W2T    = OFF_WOUT1 + 2097152;
constexpr size_t OFF_A2T    = OFF_W2T + 65536;
constexpr size_t OFF_G2T    = OFF_A2T + 65536;
constexpr size_t OFF_S5K    = OFF_G2T + 131072;
constexpr size_t OFF_S5F    = OFF_S5K + 1179648;
constexpr size_t OFF_S5E    = OFF_S5F + 8388608;
constexpr size_t OFF_S5P    = OFF_S5E + 8388608;
constexpr size_t OFF_RWT    = OFF_S5P + 16384;
constexpr size_t OFF_ROUTE  = OFF_RWT + 393216;
constexpr size_t OFF_DTRAW  = OFF_ROUTE + 786432;
constexpr size_t OFF_DTV    = OFF_DTRAW + 1048576;
constexpr size_t OFF_MOEW   = OFF_DTV + 1048576;
constexpr size_t OFF_H      = OFF_MOEW + 100663296;
constexpr size_t OFF_PROJ   = OFF_H + 67108864;
constexpr size_t OFF_MIX    = OFF_PROJ + 226492416;
constexpr size_t OFF_SCR    = OFF_MIX + 67108864;
constexpr size_t OFF_LIST   = OFF_MIX;
constexpr size_t SCR_BYTES  = 117440512;
constexpr size_t WS_NEEDED  = OFF_SCR + SCR_BYTES;
static_assert(WS_NEEDED <= 621250048ull, "workspace is exactly the sum of the inputs");
constexpr size_t OFF_PROJ0  = OFF_PROJ;
constexpr size_t OFF_YS     = OFF_PROJ + 134217728;
constexpr size_t OFF_HLOC   = OFF_PROJ + 167772160;
constexpr size_t OFF_HPREV  = OFF_PROJ + 176160768;
constexpr size_t OFF_PROJR  = OFF_PROJ;
constexpr size_t OFF_PROJM  = OFF_PROJ + 117440512;
constexpr size_t OFF_ACT    = OFF_PROJ;
constexpr size_t OFF_YEXP   = OFF_PROJ + 75497472;
constexpr size_t OFF_WGU    = OFF_MOEW;
constexpr size_t OFF_WD     = OFF_MOEW + 67108864;
constexpr size_t OFF_XBC    = OFF_H;
constexpr size_t OFF_RG     = OFF_H;
constexpr size_t OFF_RKK    = OFF_MOEW;
constexpr size_t OFF_RA     = OFF_MOEW + 33554432;
constexpr size_t OFF_RWE    = OFF_MOEW + 2 * 33554432;
constexpr size_t OFF_S5U    = OFF_SCR;
constexpr size_t OFF_XR1    = OFF_SCR;
constexpr size_t OFF_RKP    = OFF_SCR;
constexpr size_t OFF_LORAW  = OFF_SCR + 33554432;
constexpr size_t OFF_LORAA  = OFF_LORAW + 4194304;
constexpr size_t OFF_LORAG  = OFF_LORAA + 4194304;
constexpr size_t OFF_LAM    = OFF_LORAW;
constexpr size_t OFF_ST     = OFF_SCR + 50331648;
constexpr size_t OFF_ATOT   = OFF_DTRAW;
constexpr int YREC_LD = 1024;
constexpr int CTL_COUNT = 9216;
constexpr int CTL_CURSOR = 8320;
constexpr int CTL_SUBBAR = 8448;
constexpr int CTL_ATTQ = 8512;
constexpr int CTL_MOEQ = 8640;
constexpr int CTL_RWAQ = 8960;
constexpr int CTL_SSDQ = 9024;
constexpr int CTL_MOERDY = 11264;
constexpr int CTL_MOEDQ = 12416;

extern __shared__ __attribute__((aligned(16))) char g_smem[];
constexpr int HALF_LDS = 66048;
constexpr int HS_OFF = 2 * HALF_LDS;
constexpr int XST_OFF = HS_OFF + 128;
constexpr int LDS_TOTAL = XST_OFF + 64;
DEVINL int my_tid() { int t = threadIdx.x & 255; asm volatile("" : "+v"(t)); return t; }
DEVINL void hsync() {
  asm volatile("s_waitcnt lgkmcnt(0)" ::: "memory");
  if ((threadIdx.x & 63) == 0) {
    unsigned* c = (unsigned*)(g_smem + HS_OFF + (threadIdx.x >> 8) * 64);
    const unsigned v = __hip_atomic_fetch_add(c, 1u, __ATOMIC_RELAXED, __HIP_MEMORY_SCOPE_WORKGROUP);
    if ((v & 3u) != 3u) {
      const unsigned target = (v & ~3u) + 4u;
      while ((int)(__hip_atomic_load(c, __ATOMIC_RELAXED, __HIP_MEMORY_SCOPE_WORKGROUP) - target) < 0) __builtin_amdgcn_s_sleep(1);
    }
  }
  asm volatile("" ::: "memory");
}
DEVINL float bf2f(bf16_t h) { return __uint_as_float(((unsigned)h) << 16); }
typedef float f32x2_t __attribute__((ext_vector_type(2)));
typedef __bf16 hwbf16x2_t __attribute__((ext_vector_type(2)));
DEVINL unsigned pk2(float a, float b) { const f32x2_t v = {a, b}; return __builtin_bit_cast(unsigned, __builtin_convertvector(v, hwbf16x2_t)); }
DEVINL bf16_t f2bf(float f) { return __builtin_bit_cast(bf16_t, (__bf16)f); }
DEVINL float lo2f(unsigned u) { return __uint_as_float(u << 16); }
DEVINL float hi2f(unsigned u) { return __uint_as_float(u & 0xffff0000u); }
template <int CTRL> DEVINL float dpp_rot(float x) { return __int_as_float(__builtin_amdgcn_update_dpp(0, __float_as_int(x), CTRL, 0xF, 0xF, true)); }
DEVINL float wave_sum(float v) {
  v += dpp_rot<0x128>(v); v += dpp_rot<0x124>(v); v += dpp_rot<0x122>(v); v += dpp_rot<0x121>(v);
  v += __shfl_xor(v, 16); v += __shfl_xor(v, 32);
  return v;
}
DEVINL float sigmoid_(float x) { return __builtin_amdgcn_rcpf(1.f + __expf(-x)); }
DEVINL float softplus_(float x) { return fmaxf(x, 0.f) + __logf(1.f + __expf(-fabsf(x))); }
DEVINL float silu_(float x) { return x * __builtin_amdgcn_rcpf(1.f + __expf(-x)); }
DEVINL float tanh_(float x) { const float e = __expf(-2.f * fabsf(x)); const float t = (1.f - e) * __builtin_amdgcn_rcpf(1.f + e); return copysignf(t, x); }
DEVINL void st4bf_wt(bf16_t* p, float a, float b, float c, float d) {
  const unsigned long long v = (unsigned long long)pk2(a, b) | ((unsigned long long)pk2(c, d) << 32);
  __hip_atomic_store((unsigned long long*)p, v, __ATOMIC_RELAXED, __HIP_MEMORY_SCOPE_AGENT);
}
DEVINL void st4bf(bf16_t* p, float a, float b, float c, float d) { u32x2 v; v.x = pk2(a, b); v.y = pk2(c, d); *(u32x2*)p = v; }
DEVINL void ld8bf(const bf16_t* p, float* o) {
  u32x4 v = *(const u32x4*)p;
  o[0] = lo2f(v.x); o[1] = hi2f(v.x); o[2] = lo2f(v.y); o[3] = hi2f(v.y);
  o[4] = lo2f(v.z); o[5] = hi2f(v.z); o[6] = lo2f(v.w); o[7] = hi2f(v.w);
}
DEVINL void ld4bf(const bf16_t* p, float* o) {
  u32x2 v = *(const u32x2*)p;
  o[0] = lo2f(v.x); o[1] = hi2f(v.x); o[2] = lo2f(v.y); o[3] = hi2f(v.y);
}

#define GLDS16(g, l) __builtin_amdgcn_global_load_lds((const unsigned*)(g), (unsigned*)(l), 16, 0, 0)
DEVINL void gemm_core(f32x4 (&acc)[4][4], const bf16_t* const (&a)[4], long as, const bf16_t* const (&b)[4], long bs, int nk, char* lds) {
  const int tid = my_tid(), lane = tid & 63, wid = tid >> 6, wr = wid >> 1, wc = wid & 1, fr = lane & 15, fq = lane >> 4;
  const int sw = fr >> 1;
#pragma unroll
  for (int i = 0; i < 4; ++i) {
    GLDS16(a[i], lds + (tid + 256 * i) * 16);
    GLDS16(b[i], lds + 16384 + (tid + 256 * i) * 16);
  }
  for (int kt = 0; kt < nk; ++kt) {
    char* sA = lds + (kt & 1) * 32768;
    char* sB = sA + 16384;
    asm volatile("s_waitcnt vmcnt(0)" ::: "memory"); hsync();
    if (kt + 1 < nk) {
      char* nA = lds + ((kt + 1) & 1) * 32768;
#pragma unroll
      for (int i = 0; i < 4; ++i) {
        GLDS16(a[i] + (kt + 1) * as, nA + (tid + 256 * i) * 16);
        GLDS16(b[i] + (kt + 1) * bs, nA + 16384 + (tid + 256 * i) * 16);
      }
    }
#pragma unroll
    for (int kk = 0; kk < 2; ++kk) {
      bf16x8 af[4], bfr[4];
      const int so = ((kk * 4 + fq) ^ sw) * 16;
#pragma unroll
      for (int m = 0; m < 4; ++m) af[m] = *(const bf16x8*)(sA + (wr * 64 + m * 16 + fr) * 128 + so);
#pragma unroll
      for (int n = 0; n < 4; ++n) bfr[n] = *(const bf16x8*)(sB + (wc * 64 + n * 16 + fr) * 128 + so);
#pragma unroll
      for (int m = 0; m < 4; ++m)
#pragma unroll
        for (int n = 0; n < 4; ++n) acc[m][n] = __builtin_amdgcn_mfma_f32_16x16x32_bf16(bfr[n], af[m], acc[m][n], 0, 0, 0);
    }
  }
  hsync();
}
DEVINL void acc_zero(f32x4 (&acc)[4][4]) {
#pragma unroll
  for (int m = 0; m < 4; ++m)
#pragma unroll
    for (int n = 0; n < 4; ++n) acc[m][n] = (f32x4){0.f, 0.f, 0.f, 0.f};
}
#define ROWS4(name, base, row0, ld) const bf16_t* const name[4] = {(base) + (size_t)((row0) + lr) * (ld) + lc, (base) + (size_t)((row0) + lr + 32) * (ld) + lc, \
  (base) + (size_t)((row0) + lr + 64) * (ld) + lc, (base) + (size_t)((row0) + lr + 96) * (ld) + lc}
#define TILE_IDS const int tid = my_tid(), lane = tid & 63, wid = tid >> 6, wr = wid >> 1, wc = wid & 1, fr = lane & 15, fq = lane >> 4; \
  const int lr = tid >> 3, lc = ((tid & 7) ^ ((tid >> 4) & 7)) * 8; (void)lane; (void)wr; (void)wc; (void)fr; (void)fq; (void)lr; (void)lc;

DEVINL int conv_row(int n, int mode) {
  if (mode == 0) return n;
  if (mode == 1) { int j = n & 511; return (j >> 4) * 32 + (n >= 512 ? 16 : 0) + (j & 15); }
  return (n >> 4) * 32 + (mode == 3 ? 16 : 0) + (n & 15);
}
DEVINL void conv_tile(const float* src, int K, int N, int tile, bf16_t* dst, int mode, float* st  ) {
  const int tid = my_tid();
  const int ntn = (N + 63) >> 6;
  const int k0 = (tile / ntn) * 64, n0 = (tile % ntn) * 64;
  float v[16];
#pragma unroll
  for (int i = 0; i < 16; ++i) {
    int k = i * 4 + (tid >> 6), n = n0 + (tid & 63);
    v[i] = (n < N) ? __builtin_nontemporal_load(src + (size_t)(k0 + k) * N + n) : 0.f;
  }
#pragma unroll
  for (int i = 0; i < 16; ++i) st[(i * 4 + (tid >> 6)) * 65 + (tid & 63)] = v[i];
  hsync();
#pragma unroll
  for (int i = 0; i < 2; ++i) {
    int idx = tid + 256 * i, nl = idx >> 3, kc = idx & 7, n = n0 + nl;
    if (n < N) {
      const float* s = st + (kc * 8) * 65 + nl;
      u32x4 o;
      o.x = pk2(s[0], s[65]); o.y = pk2(s[130], s[195]); o.z = pk2(s[260], s[325]); o.w = pk2(s[390], s[455]);
      *(u32x4*)(dst + (size_t)conv_row(n, mode) * K + k0 + kc * 8) = o;
    }
  }
  hsync();
}

constexpr int PREP_NCONV = 512 + 128 + 256 + 848 + 256 + 8 + 8 + 16;
constexpr int PREP_ADA0 = PREP_NCONV, PREP_NADA = 192;
constexpr int PREP_S50 = PREP_ADA0 + PREP_NADA, PREP_NS5 = 32 * 65;
constexpr int PREP_RW0 = PREP_S50 + PREP_NS5, PREP_NRW = 96;
constexpr int PREP_PAD0 = PREP_RW0 + PREP_NRW, PREP_NPAD = 31;
constexpr int PREP_ITEMS = PREP_PAD0 + PREP_NPAD;

DEVINL void prep_ada(const Params& p, int item, char* smem) {
  float* cond = (float*)smem;
  float* part = cond + 8192;
  const int tid = my_tid(), lane = tid & 63, wid = tid >> 6;
  const int l = item / 96, j0 = (item % 96) * 64;
  for (int i = tid; i < 8192; i += 256) cond[i] = silu_(p.in[I_C][i]);
  hsync();
  const float* W = p.in[I_ADA_W] + (size_t)l * 1024 * 6144 + j0 + lane;
  float acc[8];
#pragma unroll
  for (int b = 0; b < 8; ++b) acc[b] = 0.f;
#pragma unroll 32
  for (int k = wid * 256; k < wid * 256 + 256; ++k) {
    float w = W[(size_t)k * 6144];
#pragma unroll
    for (int b = 0; b < 8; ++b) acc[b] += cond[b * 1024 + k] * w;
  }
#pragma unroll
  for (int b = 0; b < 8; ++b) part[(wid * 8 + b) * 64 + lane] = acc[b];
  hsync();
  float* mod = (float*)(p.ws + OFF_MOD);
  for (int i = tid; i < 512; i += 256) {
    int b = i >> 6, jj = i & 63;
    float s = part[(0 * 8 + b) * 64 + jj] + part[(1 * 8 + b) * 64 + jj] + part[(2 * 8 + b) * 64 + jj] + part[(3 * 8 + b) * 64 + jj];
    mod[((size_t)l * 8 + b) * 6144 + j0 + jj] = s + p.in[I_ADA_B][l * 6144 + j0 + jj];
  }
  hsync();
}

DEVINL void prep_s5(const Params& p, int item, char* smem) {
  float* pw_re = (float*)smem;
  float* pw_im = pw_re + 64;
  float* cf_re = pw_im + 64;
  float* cf_im = cf_re + 64;
  float* bb_re = cf_im + 64;
  float* bb_im = bb_re + 1024;
  const int tid = my_tid();
  const int g = item / 65, j = item % 65;
  if (tid < 64) {
    const int n = tid;
    const float are = fminf(p.in[I_S5_ARE][g * 64 + n], -1e-4f), aim = p.in[I_S5_AIM][g * 64 + n];
    const float dt = expf(p.in[I_S5_LOGDT][g]);
    float sn, cs;
    sincosf(dt * aim, &sn, &cs);
    const float mag = expf(dt * are), ar = mag * cs, ai = mag * sn;
    const float den = are * are + aim * aim, nr = ar - 1.f, ni = ai;
    cf_re[n] = (nr * are + ni * aim) / den;
    cf_im[n] = (ni * are - nr * aim) / den;
    const float mj = expf((float)j * dt * are);
    sincosf((float)j * dt * aim, &sn, &cs);
    pw_re[n] = mj * cs;
    pw_im[n] = mj * sn;
  }
  hsync();
  for (int i = tid; i < 1024; i += 256) {
    int n = i >> 4;
    float br = p.in[I_S5_BRE][g * 1024 + i], bi = p.in[I_S5_BIM][g * 1024 + i];
    bb_re[i] = cf_re[n] * br - cf_im[n] * bi;
    bb_im[i] = cf_re[n] * bi + cf_im[n] * br;
  }
  hsync();
  bf16_t* Kx = (bf16_t*)(p.ws + OFF_S5K);
  bf16_t* F = (bf16_t*)(p.ws + OFF_S5F);
  bf16_t* E = (bf16_t*)(p.ws + OFF_S5E);
  const float* cre = p.in[I_S5_CRE] + g * 1024;
  const float* cim = p.in[I_S5_CIM] + g * 1024;
  if (j < 8) Kx[((size_t)g * 72 + j) * 256 + tid] = 0;
  if (j < 64) {
    const int pp = tid >> 4, q = tid & 15;
    float s = 0.f;
    for (int n = 0; n < 64; ++n) {
      float xr = pw_re[n] * bb_re[n * 16 + q] - pw_im[n] * bb_im[n * 16 + q];
      float xi = pw_re[n] * bb_im[n * 16 + q] + pw_im[n] * bb_re[n * 16 + q];
      s += cre[pp * 64 + n] * xr - cim[pp * 64 + n] * xi;
    }
    Kx[((size_t)g * 72 + j + 8) * 256 + tid] = f2bf(s);
    const int sidx = 63 - j;
    for (int i = tid; i < 1024; i += 256) {
      int n = i >> 4, qq = i & 15;
      float xr = pw_re[n] * bb_re[i] - pw_im[n] * bb_im[i];
      float xi = pw_re[n] * bb_im[i] + pw_im[n] * bb_re[i];
      F[((size_t)g * 128 + n) * 1024 + sidx * 16 + qq] = f2bf(xr);
      F[((size_t)g * 128 + 64 + n) * 1024 + sidx * 16 + qq] = f2bf(xi);
    }
  }
  if (j >= 1) {
    const int t = j - 1;
    for (int i = tid; i < 1024; i += 256) {
      int pp = i >> 6, n = i & 63;
      float cr = cre[pp * 64 + n], ci = cim[pp * 64 + n];
      E[((size_t)g * 1024 + t * 16 + pp) * 128 + n] = f2bf(cr * pw_re[n] - ci * pw_im[n]);
      E[((size_t)g * 1024 + t * 16 + pp) * 128 + 64 + n] = f2bf(-(cr * pw_im[n] + ci * pw_re[n]));
    }
  }
  if (j == 64 && tid < 64) {
    float* P64 = (float*)(p.ws + OFF_S5P);
    P64[(g * 64 + tid) * 2] = pw_re[tid];
    P64[(g * 64 + tid) * 2 + 1] = pw_im[tid];
  }
  hsync();
}

DEVINL void prep_conv_item(const Params& p, int r, float* st) {
  if (r < 512) { conv_tile(p.in[I_EVEN_WIN], 1024, 2048, r, (bf16_t*)(p.ws + OFF_WIN0), 0, st); return; } r -= 512;
  if (r < 128) { conv_tile(p.in[I_S5_WGLU], 512, 1024, r, (bf16_t*)(p.ws + OFF_WGLU), 1, st); return; } r -= 128;
  if (r < 256) { conv_tile(p.in[I_EVEN_WOUT], 1024, 1024, r, (bf16_t*)(p.ws + OFF_WOUT0), 0, st); return; } r -= 256;
  if (r < 848) { conv_tile(p.in[I_ODD_WIN], 1024, 3336, r, (bf16_t*)(p.ws + OFF_WIN1), 0, st); return; } r -= 848;
  if (r < 256) { conv_tile(p.in[I_ODD_WOUT], 1024, 1024, r, (bf16_t*)(p.ws + OFF_WOUT1), 0, st); return; } r -= 256;
  if (r < 8) { conv_tile(p.in[I_RW_W2], 64, 512, r, (bf16_t*)(p.ws + OFF_W2T), 0, st); return; } r -= 8;
  if (r < 8) { conv_tile(p.in[I_RW_A2], 64, 512, r, (bf16_t*)(p.ws + OFF_A2T), 0, st); return; } r -= 8;
  conv_tile(p.in[I_RW_G2], 128, 512, r, (bf16_t*)(p.ws + OFF_G2T), 0, st);
}
constexpr int PREP_NCONV0 = 896;
DEVINL void phase_prep(const Params& p, int bid, int nb, char* smem) {
  for (int item = bid; item < PREP_ITEMS; item += nb) {
    if (item < PREP_NCONV) {
      if (item < PREP_NCONV0) prep_conv_item(p, item, (float*)smem);
    } else if (item < PREP_S50) {
      prep_ada(p, item - PREP_ADA0, smem);
    } else if (item < PREP_RW0) {
      prep_s5(p, item - PREP_S50, smem);
    } else if (item < PREP_PAD0) {
      const int r = item - PREP_RW0, l = r / 48, o = r % 48;
      bf16_t* dst = (bf16_t*)(p.ws + OFF_RWT) + (size_t)l * 98304;
      for (int k = my_tid(); k < 1024; k += 256) {
        const float w = (o >= 36) ? 0.f : (o < 4) ? p.in[I_MOE_WGRP][((size_t)l * 1024 + k) * 4 + o] : p.in[I_MOE_WEXP][((size_t)l * 1024 + k) * 32 + (o - 4)];
        const bf16_t hi = f2bf(w), lo = f2bf(w - bf2f(hi));
        const size_t off = ((size_t)(((k >> 5) * 3 + (o >> 4)) * 2) * 64 + ((k >> 3) & 3) * 16 + (o & 15)) * 8 + (k & 7);
        dst[off] = hi; dst[off + 512] = lo;
      }
    } else {
      const int r = item - PREP_PAD0;
      u32x4* dst = (u32x4*)((bf16_t*)(p.ws + OFF_WIN1) + (size_t)(3336 + r * 8) * 1024);
      for (int i = my_tid(); i < 1024; i += 256) dst[i] = (u32x4){0u, 0u, 0u, 0u};
    }
  }
}
DEVINL void phase_prep_l1(const Params& p, int bid, int nb, char* smem) {
  for (int item = PREP_NCONV0 + bid; item < PREP_NCONV; item += nb) prep_conv_item(p, item, (float*)smem);
}

DEVINL void phase_moe_convert(const Params& p, int bid, int nb, int L, char* smem, int item0 = 0, int item1 = 12288) {
  float* st = (float*)smem;
  for (int item = item0 + bid; item < item1; item += nb) {
    const int e = item / 384, r = item % 384;
    const size_t eoff = ((size_t)L * 32 + e) * 524288;
    if (r < 128) conv_tile(p.in[I_MOE_WGATE] + eoff, 1024, 512, r, (bf16_t*)(p.ws + OFF_WGU) + (size_t)e * 1048576, 2, st);
    else if (r < 256) conv_tile(p.in[I_MOE_WUP] + eoff, 1024, 512, r - 128, (bf16_t*)(p.ws + OFF_WGU) + (size_t)e * 1048576, 3, st);
    else conv_tile(p.in[I_MOE_WDOWN] + eoff, 512, 1024, r - 256, (bf16_t*)(p.ws + OFF_WD) + (size_t)e * 524288, 0, st);
  }
}

DEVINL void moe_prefix(const Params& p, int L, int* pad_start  ) {
  const int* ctl = (const int*)(p.ws + OFF_CTL);
  if (my_tid() == 0) {
    int s = 0;
    for (int e = 0; e < 32; ++e) { pad_start[e] = s; s += ((ctl[CTL_COUNT + (L * 32 + e) * 32] + 255) >> 8) << 8; }
    pad_start[32] = s;
  }
  hsync();
}
DEVINL void route_flush(const Params& p, int L, const int* pend, int n, int lane) {
  __builtin_amdgcn_wave_barrier();
  if (lane < n) {
    int* ctl = (int*)(p.ws + OFF_CTL);
    int* ri = (int*)(p.ws + OFF_ROUTE);
    int* list = (int*)(p.ws + OFF_LIST);
    const int tok = pend[lane * 4], e0 = pend[lane * 4 + 1], e1 = pend[lane * 4 + 2];
    const int p0 = atomicAdd(&ctl[CTL_COUNT + (L * 32 + e0) * 32], 1);
    const int p1 = atomicAdd(&ctl[CTL_COUNT + (L * 32 + e1) * 32], 1);
    ri[0 * T + tok] = e0; ri[1 * T + tok] = e1; ri[4 * T + tok] = p0; ri[5 * T + tok] = p1;
    list[(size_t)e0 * T + p0] = tok; list[(size_t)e1 * T + p1] = tok;
  }
  __builtin_amdgcn_wave_barrier();
}
template <int CTRL> DEVINL float dpp_mov_(float x) { return __int_as_float(__builtin_amdgcn_update_dpp(0, __float_as_int(x), CTRL, 0xF, 0xF, true)); }
DEVINL float wave_sum_fast(float v) {
  v += dpp_mov_<0x128>(v); v += dpp_mov_<0x124>(v); v += dpp_mov_<0x122>(v); v += dpp_mov_<0x121>(v);
  v += __shfl_xor(v, 16); v += __shfl_xor(v, 32);
  return v;
}
DEVINL void phase_norm_router(const Params& p, int bid, int nb, int L, char* smem) {
  const int tid = my_tid(), lane = tid & 63, wid = tid >> 6, fr = lane & 15, fq = lane >> 4;
  float* wsc = (float*)smem;
  float* shf = wsc + 1024;
  float* slog = (float*)(smem + 8192) + wid * (16 * 49);
  int* lcnt = (int*)(smem + 8192 + 12544);
  int* lbase = lcnt + 32;
  const float* mod = (const float*)(p.ws + OFF_MOD);
  bf16_t* H = (bf16_t*)(p.ws + OFF_H);
  const float* nw = p.in[I_NORM_FFN] + L * 1024;
  const bf16_t* Wf = (const bf16_t*)(p.ws + OFF_RWT) + (size_t)L * 98304 + lane * 8;
  const bf16_t* xres = (L == 0) ? (const bf16_t*)p.out : (const bf16_t*)(p.ws + OFF_XR1);
  for (int tile = bid; tile < T / 64; tile += nb) {
    const int row0 = tile * 64 + wid * 16, b = row0 >> 12;
    const float* shift = mod + ((size_t)L * 8 + b) * 6144 + 3 * 1024;
    const float* scale = shift + 1024;
    hsync();
    {
      const int c = tid * 4;
      const f32x4 w = *(const f32x4*)(nw + c), sc = *(const f32x4*)(scale + c), sh = *(const f32x4*)(shift + c);
      *(f32x4*)(wsc + c) = (f32x4){w.x * (1.f + sc.x), w.y * (1.f + sc.y), w.z * (1.f + sc.z), w.w * (1.f + sc.w)};
      *(f32x4*)(shf + c) = sh;
      if (tid < 32) lcnt[tid] = 0;
    }
    const bf16_t* xrow = xres + (size_t)(row0 + fr) * 1024 + 8 * fq;
    float ss = 0.f;
#pragma unroll 16
    for (int s2 = 0; s2 < 32; ++s2) {
      const u32x4 x = *(const u32x4*)(xrow + 32 * s2);
      const float a0 = lo2f(x.x), a1 = hi2f(x.x), a2 = lo2f(x.y), a3 = hi2f(x.y), a4 = lo2f(x.z), a5 = hi2f(x.z), a6 = lo2f(x.w), a7 = hi2f(x.w);
      ss += a0 * a0 + a1 * a1 + a2 * a2 + a3 * a3 + a4 * a4 + a5 * a5 + a6 * a6 + a7 * a7;
    }
    ss += __shfl_xor(ss, 16); ss += __shfl_xor(ss, 32);
    const float rstd = rsqrtf(ss * (1.f / 1024.f) + 1e-6f);
    hsync();
    f32x4 acc[3];
#pragma unroll
    for (int n = 0; n < 3; ++n) acc[n] = (f32x4){0.f, 0.f, 0.f, 0.f};
    bf16_t* hrow = H + (size_t)(row0 + fr) * 1024 + 8 * fq;
#pragma unroll 1
    for (int s4 = 0; s4 < 32; s4 += 4) {
     u32x4 phs[4];
#pragma unroll
     for (int su = 0; su < 4; ++su) {
      const int s2 = s4 + su;
      const int col0 = 32 * s2 + 8 * fq;
      const u32x4 x = *(const u32x4*)(xrow + 32 * s2);
      bf16x8 wh[3], wl[3];
#pragma unroll
      for (int n = 0; n < 3; ++n) { wh[n] = *(const bf16x8*)(Wf + (size_t)((s2 * 3 + n) * 2) * 512); wl[n] = *(const bf16x8*)(Wf + (size_t)((s2 * 3 + n) * 2 + 1) * 512); }
      const f32x4 w0 = *(const f32x4*)(wsc + col0), w1 = *(const f32x4*)(wsc + col0 + 4), s0 = *(const f32x4*)(shf + col0), s1 = *(const f32x4*)(shf + col0 + 4);
      float h[8];
      h[0] = lo2f(x.x) * rstd * w0.x + s0.x; h[1] = hi2f(x.x) * rstd * w0.y + s0.y; h[2] = lo2f(x.y) * rstd * w0.z + s0.z; h[3] = hi2f(x.y) * rstd * w0.w + s0.w;
      h[4] = lo2f(x.z) * rstd * w1.x + s1.x; h[5] = hi2f(x.z) * rstd * w1.y + s1.y; h[6] = lo2f(x.w) * rstd * w1.z + s1.z; h[7] = hi2f(x.w) * rstd * w1.w + s1.w;
      u32x4 ph, pl;
      {
        bf16_t q[8];
#pragma unroll
        for (int j = 0; j < 8; ++j) q[j] = f2bf(h[j]);
        ph.x = (unsigned)q[0] | ((unsigned)q[1] << 16); ph.y = (unsigned)q[2] | ((unsigned)q[3] << 16);
        ph.z = (unsigned)q[4] | ((unsigned)q[5] << 16); ph.w = (unsigned)q[6] | ((unsigned)q[7] << 16);
        pl.x = pk2(h[0] - bf2f(q[0]), h[1] - bf2f(q[1])); pl.y = pk2(h[2] - bf2f(q[2]), h[3] - bf2f(q[3]));
        pl.z = pk2(h[4] - bf2f(q[4]), h[5] - bf2f(q[5])); pl.w = pk2(h[6] - bf2f(q[6]), h[7] - bf2f(q[7]));
      }
      phs[su] = ph;
      const bf16x8 xh = __builtin_bit_cast(bf16x8, ph), xl = __builtin_bit_cast(bf16x8, pl);
#pragma unroll
      for (int n = 0; n < 3; ++n) {
        acc[n] = __builtin_amdgcn_mfma_f32_16x16x32_bf16(wh[n], xh, acc[n], 0, 0, 0);
        acc[n] = __builtin_amdgcn_mfma_f32_16x16x32_bf16(wl[n], xh, acc[n], 0, 0, 0);
        acc[n] = __builtin_amdgcn_mfma_f32_16x16x32_bf16(wh[n], xl, acc[n], 0, 0, 0);
      }
     }
#pragma unroll
     for (int su = 0; su < 4; ++su) *(u32x4*)(hrow + 32 * (s4 + su)) = phs[su];
    }
#pragma unroll
    for (int n = 0; n < 3; ++n) {
      slog[fr * 49 + 16 * n + 4 * fq + 0] = acc[n].x; slog[fr * 49 + 16 * n + 4 * fq + 1] = acc[n].y;
      slog[fr * 49 + 16 * n + 4 * fq + 2] = acc[n].z; slog[fr * 49 + 16 * n + 4 * fq + 3] = acc[n].w;
    }
    __builtin_amdgcn_wave_barrier();
    int e0 = 0, e1 = 0, r0 = 0, r1 = 0;
    if (lane < 16) {
      const float* lg = slog + lane * 49;
      const int row = row0 + lane;
      float gl[4];
#pragma unroll
      for (int i = 0; i < 4; ++i) gl[i] = lg[i] + p.in[I_MOE_BGRP][L * 4 + i];
      int gi = 0; float gm = gl[0];
#pragma unroll
      for (int i = 1; i < 4; ++i) if (gl[i] > gm) { gm = gl[i]; gi = i; }
      float den = 0.f;
#pragma unroll
      for (int i = 0; i < 4; ++i) den += expf(gl[i] - gm);
      const float grp_p = 1.f / den;
      float el[8];
#pragma unroll
      for (int i = 0; i < 8; ++i) el[i] = lg[4 + gi * 8 + i] + p.in[I_MOE_BEXP][L * 32 + gi * 8 + i];
      int i0 = 0; float m0 = el[0];
#pragma unroll
      for (int i = 1; i < 8; ++i) if (el[i] > m0) { m0 = el[i]; i0 = i; }
      int i1 = -1; float m1 = -3.0e38f;
#pragma unroll
      for (int i = 0; i < 8; ++i) if (i != i0 && el[i] > m1) { m1 = el[i]; i1 = i; }
      const float p0 = 1.f / (1.f + expf(m1 - m0));
      const float p1 = 1.f - p0;
      float* rf = (float*)(p.ws + OFF_ROUTE);
      rf[2 * T + row] = grp_p * p0; rf[3 * T + row] = grp_p * p1;
      e0 = gi * 8 + i0; e1 = gi * 8 + i1;
      r0 = atomicAdd(&lcnt[e0], 1); r1 = atomicAdd(&lcnt[e1], 1);
    }
    hsync();
    if (tid < 32) { const int c = lcnt[tid]; lbase[tid] = (c > 0) ? atomicAdd((int*)(p.ws + OFF_CTL) + CTL_COUNT + (L * 32 + tid) * 32, c) : 0; }
    hsync();
    if (lane < 16) {
      const int tok = row0 + lane, q0 = lbase[e0] + r0, q1 = lbase[e1] + r1;
      int* ri = (int*)(p.ws + OFF_ROUTE);
      int* list = (int*)(p.ws + OFF_LIST);
      ri[0 * T + tok] = e0; ri[1 * T + tok] = e1; ri[4 * T + tok] = q0; ri[5 * T + tok] = q1;
      list[(size_t)e0 * T + q0] = tok; list[(size_t)e1 * T + q1] = tok;
    }
  }
}
DEVINL void phase_norm(const Params& p, int bid, int nb, int mode, int L, char* smem) {
  const int tid = my_tid(), lane = tid & 63, wid = tid >> 6;
  int* pad_start = (int*)smem;
  if (mode >= 2) moe_prefix(p, (mode == 2) ? L - 1 : L, pad_start);
  const float* xin = p.in[I_X];
  const bf16_t* xres = (mode == 3) ? (const bf16_t*)(p.ws + OFF_XR1) : (const bf16_t*)p.out;
  const float* mod = (const float*)(p.ws + OFF_MOD);
  bf16_t* H = (bf16_t*)(p.ws + OFF_H);
  const int* rt_i = (const int*)(p.ws + OFF_ROUTE);
  const float* rt_f = (const float*)(p.ws + OFF_ROUTE);
  const bf16_t* Y = (const bf16_t*)(p.ws + OFF_YEXP);
  const int Lc = (mode == 2) ? L - 1 : L;
  const float* nw = (mode == 3) ? p.in[I_FINAL_W] : p.in[I_NORM_MIX] + L * 1024;
  const int nwaves = nb * 4;
  for (int row0 = (bid * 4 + wid) * 2; row0 < T; row0 += nwaves * 2) {
    const int b = row0 >> 12;
    f32x4 v[2][4];
    if (mode == 0) {
#pragma unroll
      for (int r = 0; r < 2; ++r)
#pragma unroll
        for (int j = 0; j < 4; ++j) v[r][j] = *(const f32x4*)(xin + (size_t)(row0 + r) * 1024 + j * 256 + lane * 4);
    } else {
      u32x2 xr[2][4];
#pragma unroll
      for (int r = 0; r < 2; ++r)
#pragma unroll
        for (int j = 0; j < 4; ++j) xr[r][j] = *(const u32x2*)(xres + (size_t)(row0 + r) * 1024 + j * 256 + lane * 4);
      if (mode >= 2) {
        int s0[2], s1[2]; float g0[2], g1[2];
#pragma unroll
        for (int r = 0; r < 2; ++r) {
          const int row = row0 + r;
          s0[r] = pad_start[rt_i[0 * T + row]] + rt_i[4 * T + row]; s1[r] = pad_start[rt_i[1 * T + row]] + rt_i[5 * T + row];
          g0[r] = rt_f[2 * T + row]; g1[r] = rt_f[3 * T + row];
        }
        u32x2 ya[2][4], yb[2][4];
#pragma unroll
        for (int r = 0; r < 2; ++r)
#pragma unroll
          for (int j = 0; j < 4; ++j) {
            ya[r][j] = *(const u32x2*)(Y + (size_t)s0[r] * 1024 + j * 256 + lane * 4);
            yb[r][j] = *(const u32x2*)(Y + (size_t)s1[r] * 1024 + j * 256 + lane * 4);
          }
        const float* gate2 = mod + ((size_t)Lc * 8 + b) * 6144 + 5 * 1024;
#pragma unroll
        for (int j = 0; j < 4; ++j) {
          const f32x4 gt = *(const f32x4*)(gate2 + j * 256 + lane * 4);
#pragma unroll
          for (int r = 0; r < 2; ++r) {
            v[r][j].x = lo2f(xr[r][j].x) + gt.x * (g0[r] * lo2f(ya[r][j].x) + g1[r] * lo2f(yb[r][j].x));
            v[r][j].y = hi2f(xr[r][j].x) + gt.y * (g0[r] * hi2f(ya[r][j].x) + g1[r] * hi2f(yb[r][j].x));
            v[r][j].z = lo2f(xr[r][j].y) + gt.z * (g0[r] * lo2f(ya[r][j].y) + g1[r] * lo2f(yb[r][j].y));
            v[r][j].w = hi2f(xr[r][j].y) + gt.w * (g0[r] * hi2f(ya[r][j].y) + g1[r] * hi2f(yb[r][j].y));
          }
        }
        if (mode == 2) {
#pragma unroll
          for (int r = 0; r < 2; ++r)
#pragma unroll
            for (int j = 0; j < 4; ++j) st4bf((bf16_t*)p.out + (size_t)(row0 + r) * 1024 + j * 256 + lane * 4, v[r][j].x, v[r][j].y, v[r][j].z, v[r][j].w);
        }
      } else {
#pragma unroll
        for (int r = 0; r < 2; ++r)
#pragma unroll
          for (int j = 0; j < 4; ++j) v[r][j] = (f32x4){lo2f(xr[r][j].x), hi2f(xr[r][j].x), lo2f(xr[r][j].y), hi2f(xr[r][j].y)};
      }
    }
    float rstd[2];
#pragma unroll
    for (int r = 0; r < 2; ++r) {
      float ss = 0.f;
#pragma unroll
      for (int j = 0; j < 4; ++j) ss += v[r][j].x * v[r][j].x + v[r][j].y * v[r][j].y + v[r][j].z * v[r][j].z + v[r][j].w * v[r][j].w;
      ss = wave_sum(ss);
      rstd[r] = rsqrtf(ss * (1.f / 1024.f) + 1e-6f);
    }
    if (mode == 3) {
#pragma unroll
      for (int j = 0; j < 4; ++j) {
        const int c = j * 256 + lane * 4;
        const f32x4 w = *(const f32x4*)(nw + c);
#pragma unroll
        for (int r = 0; r < 2; ++r) {
          f32x4 o; o.x = v[r][j].x * rstd[r] * w.x; o.y = v[r][j].y * rstd[r] * w.y; o.z = v[r][j].z * rstd[r] * w.z; o.w = v[r][j].w * rstd[r] * w.w;
          *(f32x4*)(p.out + (size_t)(row0 + r) * 1024 + c) = o;
        }
      }
      continue;
    }
    const float* shift = mod + ((size_t)L * 8 + b) * 6144;
    const float* scale = shift + 1024;
#pragma unroll
    for (int j = 0; j < 4; ++j) {
      const int c = j * 256 + lane * 4;
      const f32x4 w = *(const f32x4*)(nw + c), sc = *(const f32x4*)(scale + c), sh = *(const f32x4*)(shift + c);
#pragma unroll
      for (int r = 0; r < 2; ++r)
        st4bf(H + (size_t)(row0 + r) * 1024 + c, v[r][j].x * rstd[r] * w.x * (1.f + sc.x) + sh.x, v[r][j].y * rstd[r] * w.y * (1.f + sc.y) + sh.y,
              v[r][j].z * rstd[r] * w.z * (1.f + sc.z) + sh.z, v[r][j].w * rstd[r] * w.w * (1.f + sc.w) + sh.w);
    }
  }
}
DEVINL void phase_inproj0(const Params& p, int bid, int nb, char* smem) {
  TILE_IDS
  const bf16_t* A = (const bf16_t*)(p.ws + OFF_H);
  const bf16_t* B = (const bf16_t*)(p.ws + OFF_WIN0);
  bf16_t* C = (bf16_t*)(p.ws + OFF_PROJ0);
  for (int tile = bid; tile < 256 * 16; tile += nb) {
    const int xj = tile >> 3, mt = (xj >> 4) * 8 + (tile & 7), nt = xj & 15;
    ROWS4(ap, A, mt * 128, 1024);
    ROWS4(bp, B, nt * 128, 1024);
    f32x4 acc[4][4]; acc_zero(acc);
    gemm_core(acc, ap, 64, bp, 64, 16, smem);
#pragma unroll
    for (int m = 0; m < 4; ++m)
#pragma unroll
      for (int n = 0; n < 4; ++n) {
        const int row = mt * 128 + wr * 64 + m * 16 + fr, col = nt * 128 + wc * 64 + n * 16 + fq * 4;
        st4bf(C + (size_t)row * 2048 + col, acc[m][n].x, acc[m][n].y, acc[m][n].z, acc[m][n].w);
      }
  }
}
DEVINL void phase_inproj1(const Params& p, int bid, int nb, char* smem) {
  TILE_IDS
  const bf16_t* A = (const bf16_t*)(p.ws + OFF_H);
  const bf16_t* B = (const bf16_t*)(p.ws + OFF_WIN1);
  bf16_t* CR = (bf16_t*)(p.ws + OFF_PROJR);
  bf16_t* CM = (bf16_t*)(p.ws + OFF_PROJM);
  float* DT = (float*)(p.ws + OFF_DTRAW);
  for (int tile = bid; tile < 256 * 27; tile += nb) {
    const int xj = tile >> 3, mt = (xj / 27) * 8 + (tile & 7), nt = xj % 27;
    ROWS4(ap, A, mt * 128, 1024);
    ROWS4(bp, B, nt * 128, 1024);
    f32x4 acc[4][4]; acc_zero(acc);
    gemm_core(acc, ap, 64, bp, 64, 16, smem);
#pragma unroll
    for (int m = 0; m < 4; ++m)
#pragma unroll
      for (int n = 0; n < 4; ++n) {
        const int row = mt * 128 + wr * 64 + m * 16 + fr, col = nt * 128 + wc * 64 + n * 16 + fq * 4;
        if (col < 1792) st4bf(CR + (size_t)row * 1792 + col, acc[m][n].x, acc[m][n].y, acc[m][n].z, acc[m][n].w);
        else {
          st4bf(CM + (size_t)row * 1664 + (col - 1792), acc[m][n].x, acc[m][n].y, acc[m][n].z, acc[m][n].w);
          if (col >= 3328 && col < 3336) *(f32x4*)(DT + (size_t)row * 8 + (col - 3328)) = acc[m][n];
        }
      }
  }
}
DEVINL void phase_glu(const Params& p, int bid, int nb, char* smem) {
  TILE_IDS
  const bf16_t* A = (const bf16_t*)(p.ws + OFF_YS);
  const bf16_t* B = (const bf16_t*)(p.ws + OFF_WGLU);
  bf16_t* C = (bf16_t*)(p.ws + OFF_MIX);
  for (int tile = bid; tile < 256 * 8; tile += nb) {
    const int xj = tile >> 3, mt = (xj >> 3) * 8 + (tile & 7), nt = xj & 7;
    ROWS4(ap, A, mt * 128, 512);
    ROWS4(bp, B, nt * 128, 512);
    f32x4 acc[4][4]; acc_zero(acc);
    gemm_core(acc, ap, 64, bp, 64, 8, smem);
#pragma unroll
    for (int m = 0; m < 4; ++m)
#pragma unroll
      for (int n = 0; n < 4; n += 2) {
        const int row = mt * 128 + wr * 64 + m * 16 + fr;
        const int col = (nt * 4 + wc * 2 + (n >> 1)) * 16 + fq * 4;
        f32x4 a = acc[m][n], g = acc[m][n + 1];
        st4bf(C + (size_t)row * 1024 + col, a.x * sigmoid_(g.x), a.y * sigmoid_(g.y), a.z * sigmoid_(g.z), a.w * sigmoid_(g.w));
      }
  }
}
DEVINL void phase_outproj(const Params& p, int bid, int nb, int L, char* smem) {
  TILE_IDS
  const bf16_t* A = (const bf16_t*)(p.ws + OFF_MIX);
  const bf16_t* B = (const bf16_t*)(p.ws + (L == 0 ? OFF_WOUT0 : OFF_WOUT1));
  const float* xin = (L == 0) ? p.in[I_X] : p.out;
  const float* mod = (const float*)(p.ws + OFF_MOD);
  for (int tile = bid; tile < 256 * 8; tile += nb) {
    const int xj = tile >> 3, mt = (xj >> 3) * 8 + (tile & 7), nt = xj & 7;
    ROWS4(ap, A, mt * 128, 1024);
    ROWS4(bp, B, nt * 128, 1024);
    f32x4 acc[4][4]; acc_zero(acc);
    gemm_core(acc, ap, 64, bp, 64, 16, smem);
    const int b = (mt * 128) >> 12;
    const float* gate1 = mod + ((size_t)L * 8 + b) * 6144 + 2 * 1024;
#pragma unroll
    for (int m = 0; m < 4; ++m)
#pragma unroll
      for (int n = 0; n < 4; ++n) {
        const int row = mt * 128 + wr * 64 + m * 16 + fr, col = nt * 128 + wc * 64 + n * 16 + fq * 4;
        f32x4 x = *(const f32x4*)(xin + (size_t)row * 1024 + col), g = *(const f32x4*)(gate1 + col), o;
        o.x = x.x + g.x * acc[m][n].x; o.y = x.y + g.y * acc[m][n].y; o.z = x.z + g.z * acc[m][n].z; o.w = x.w + g.w * acc[m][n].w;
        *(f32x4*)(p.out + (size_t)row * 1024 + col) = o;
      }
  }
}
DEVINL void phase_moe_gu(const Params& p, int bid, int nb, int L, char* smem) {
  TILE_IDS
  int* pad_start = (int*)(smem + 65536 + 64);
  moe_prefix(p, L, pad_start);
  const bf16_t* Hh = (const bf16_t*)(p.ws + OFF_H);
  const bf16_t* W = (const bf16_t*)(p.ws + OFF_WGU);
  const int* list = (const int*)(p.ws + OFF_LIST);
  bf16_t* ACT = (bf16_t*)(p.ws + OFF_ACT);
  const int total = pad_start[32];
  int* sQ = pad_start + 40;
  unsigned* q = (unsigned*)(p.ws + OFF_CTL) + CTL_MOEQ + (L * 2 + 0) * 64;
  const int ntiles = (total >> 7) * 8;
  for (;;) {
    hsync();
    if (tid == 0) sQ[0] = (int)atomicAdd(q, 1u);
    hsync();
    const int tile = sQ[0];
    if (tile >= ntiles) break;
    const int ti = tile >> 3, nt = tile & 7;
    int e = 0;
    while (pad_start[e + 1] <= ti * 128) ++e;
    int tk[4];
    {
      const int cnt_e = ((const int*)(p.ws + OFF_CTL))[CTL_COUNT + (L * 32 + e) * 32], pos0 = ti * 128 - pad_start[e];
#pragma unroll
      for (int i = 0; i < 4; ++i) { const int pos = pos0 + lr + 32 * i; tk[i] = (pos < cnt_e) ? list[(size_t)e * T + pos] : 0; }
    }
    const bf16_t* const ap[4] = {Hh + (size_t)tk[0] * 1024 + lc, Hh + (size_t)tk[1] * 1024 + lc, Hh + (size_t)tk[2] * 1024 + lc, Hh + (size_t)tk[3] * 1024 + lc};
    ROWS4(bp, W, e * 1024 + nt * 128, 1024);
    f32x4 acc[4][4]; acc_zero(acc);
    gemm_core(acc, ap, 64, bp, 64, 16, smem);
#pragma unroll
    for (int m = 0; m < 4; ++m)
#pragma unroll
      for (int n = 0; n < 4; n += 2) {
        const int row = ti * 128 + wr * 64 + m * 16 + fr;
        const int col = (nt * 4 + wc * 2 + (n >> 1)) * 16 + fq * 4;
        f32x4 g = acc[m][n], u = acc[m][n + 1];
        st4bf(ACT + (size_t)row * 512 + col, silu_(g.x) * u.x, silu_(g.y) * u.y, silu_(g.z) * u.z, silu_(g.w) * u.w);
      }
  }
}
DEVINL void phase_moe_down(const Params& p, int bid, int nb, int L, char* smem) {
  TILE_IDS
  int* pad_start = (int*)(smem + 65536 + 64);
  moe_prefix(p, L, pad_start);
  const bf16_t* A = (const bf16_t*)(p.ws + OFF_ACT);
  const bf16_t* W = (const bf16_t*)(p.ws + OFF_WD);
  bf16_t* Y = (bf16_t*)(p.ws + OFF_YEXP);
  const int total = pad_start[32];
  int* sQ = pad_start + 40;
  unsigned* q = (unsigned*)(p.ws + OFF_CTL) + CTL_MOEQ + (L * 2 + 1) * 64;
  const int ntiles = (total >> 7) * 8;
  for (;;) {
    hsync();
    if (tid == 0) sQ[0] = (int)atomicAdd(q, 1u);
    hsync();
    const int tile = sQ[0];
    if (tile >= ntiles) break;
    const int ti = tile >> 3, nt = tile & 7;
    int e = 0;
    while (pad_start[e + 1] <= ti * 128) ++e;
    ROWS4(ap, A, ti * 128, 512);
    ROWS4(bp, W, e * 1024 + nt * 128, 512);
    f32x4 acc[4][4]; acc_zero(acc);
    gemm_core(acc, ap, 64, bp, 64, 8, smem);
#pragma unroll
    for (int m = 0; m < 4; ++m)
#pragma unroll
      for (int n = 0; n < 4; ++n) {
        const int row = ti * 128 + wr * 64 + m * 16 + fr, col = nt * 128 + wc * 64 + n * 16 + fq * 4;
        st4bf(Y + (size_t)row * 1024 + col, acc[m][n].x, acc[m][n].y, acc[m][n].z, acc[m][n].w);
      }
  }
}

DEVINL float gelu_tanh(float x) {
  const float k = 0.7978845608028654f;
  return 0.5f * x * (1.f + tanh_(k * (x + 0.044715f * x * x * x)));
}

DEVINL void phase_s5_a(const Params& p, int bid, int nb, char* smem) {
  TILE_IDS
  const bf16_t* U = (const bf16_t*)(p.ws + OFF_S5U);
  const bf16_t* F = (const bf16_t*)(p.ws + OFF_S5F);
  float* HLOC = (float*)(p.ws + OFF_HLOC);
  for (int tile = bid; tile < 128; tile += nb) {
    const int g = tile >> 2, mt = tile & 3;
    const bf16_t* a0 = U + (((size_t)g * T + (mt * 128 + lr) * 64 + (lc >> 4)) * 16 + (lc & 15));
    const bf16_t* const ap[4] = {a0, a0 + (size_t)32 * 64 * 16, a0 + (size_t)64 * 64 * 16, a0 + (size_t)96 * 64 * 16};
    ROWS4(bp, F, g * 128, 1024);
    f32x4 acc[4][4]; acc_zero(acc);
    gemm_core(acc, ap, 4 * 16, bp, 64, 16, smem);
#pragma unroll
    for (int m = 0; m < 4; ++m)
#pragma unroll
      for (int n = 0; n < 4; ++n) {
        const int chunk = mt * 128 + wr * 64 + m * 16 + fr, n2 = wc * 64 + n * 16 + fq * 4;
        *(f32x4*)(HLOC + ((size_t)chunk * 32 + g) * 128 + n2) = acc[m][n];
      }
  }
}
DEVINL void phase_s5_scan(const Params& p, int bid, int nb, char* smem) {
  const float* HLOC = (const float*)(p.ws + OFF_HLOC);
  bf16_t* HPREV = (bf16_t*)(p.ws + OFF_HPREV);
  const float* P64 = (const float*)(p.ws + OFF_S5P);
  for (int id = bid * 256 + my_tid(); id < 16384; id += nb * 256) {
    const int n = id & 63, g = (id >> 6) & 31, b = id >> 11;
    const float pr = P64[(g * 64 + n) * 2], pi = P64[(g * 64 + n) * 2 + 1];
    float hr = 0.f, hi = 0.f;
#pragma unroll 8
    for (int c = 0; c < 64; ++c) {
      const size_t base = ((size_t)(b * 64 + c) * 32 + g) * 128;
      HPREV[base + n] = f2bf(hr); HPREV[base + 64 + n] = f2bf(hi);
      const float lr_ = HLOC[base + n], li = HLOC[base + 64 + n];
      const float nr = pr * hr - pi * hi + lr_, ni = pr * hi + pi * hr + li;
      hr = nr; hi = ni;
    }
  }
}
DEVINL void phase_s5_b(const Params& p, int bid, int nb, char* smem) {
  TILE_IDS
  const bf16_t* U = (const bf16_t*)(p.ws + OFF_S5U);
  const bf16_t* Kx = (const bf16_t*)(p.ws + OFF_S5K);
  const bf16_t* E = (const bf16_t*)(p.ws + OFF_S5E);
  const bf16_t* HPREV = (const bf16_t*)(p.ws + OFF_HPREV);
  bf16_t* YS = (bf16_t*)(p.ws + OFF_YS);
  for (int tile = bid; tile < 1024; tile += nb) {
    const int nt = 7 - (tile >> 7), g = (tile >> 2) & 31, mt = tile & 3;
    const bf16_t* a0 = U + (((size_t)g * T + (mt * 128 + lr) * 64 + (lc >> 4)) * 16 + (lc & 15));
    const bf16_t* const ap[4] = {a0, a0 + (size_t)32 * 64 * 16, a0 + (size_t)64 * 64 * 16, a0 + (size_t)96 * 64 * 16};
    const int t0 = nt * 8 + (lr >> 4);
    const bf16_t* b0 = Kx + ((size_t)g * 72 + (t0 - (lc >> 4) + 8)) * 256 + (lr & 15) * 16 + (lc & 15);
    const bf16_t* const bp[4] = {b0, b0 + 2 * 256, b0 + 4 * 256, b0 + 6 * 256};
    f32x4 acc[4][4]; acc_zero(acc);
    gemm_core(acc, ap, 4 * 16, bp, -1024, 2 * (nt + 1), smem);
    const bf16_t* a0c = HPREV + ((size_t)(mt * 128 + lr) * 32 + g) * 128 + lc;
    const bf16_t* const apc[4] = {a0c, a0c + (size_t)32 * 32 * 128, a0c + (size_t)64 * 32 * 128, a0c + (size_t)96 * 32 * 128};
    ROWS4(bpc, E, g * 1024 + nt * 128, 128);
    gemm_core(acc, apc, 64, bpc, 64, 2, smem);
#pragma unroll
    for (int m = 0; m < 4; ++m)
#pragma unroll
      for (int n = 0; n < 4; ++n) {
        const int chunk = mt * 128 + wr * 64 + m * 16 + fr, t = nt * 8 + wc * 4 + n, pp = fq * 4;
        const size_t row = (size_t)chunk * 64 + t;
        float u[4];
        ld4bf(U + ((size_t)g * T + row) * 16 + pp, u);
        const float* dsk = p.in[I_S5_D] + g * 16 + pp;
        st4bf(YS + row * 512 + g * 16 + pp, gelu_tanh(acc[m][n].x + dsk[0] * u[0]), gelu_tanh(acc[m][n].y + dsk[1] * u[1]),
              gelu_tanh(acc[m][n].z + dsk[2] * u[2]), gelu_tanh(acc[m][n].w + dsk[3] * u[3]));
      }
  }
}
DEVINL void tr_frags_64x64(const bf16_t* tile, int fr, int fq, bf16x8 (&f)[2][4]) {
  const unsigned base = (unsigned)(uintptr_t)((__attribute__((address_space(3))) char*)tile) + (unsigned)(((8 * fq + (fr >> 2)) * 72 + 4 * (fr & 3)) * 2);
  u32x2 t0, t1, t2, t3, t4, t5, t6, t7, u0, u1, u2, u3, u4, u5, u6, u7;
  asm volatile("ds_read_b64_tr_b16 %0, %16\n\tds_read_b64_tr_b16 %1, %16 offset:576\n\tds_read_b64_tr_b16 %2, %16 offset:32\n\tds_read_b64_tr_b16 %3, %16 offset:608\n\t"
               "ds_read_b64_tr_b16 %4, %16 offset:64\n\tds_read_b64_tr_b16 %5, %16 offset:640\n\tds_read_b64_tr_b16 %6, %16 offset:96\n\tds_read_b64_tr_b16 %7, %16 offset:672\n\t"
               "ds_read_b64_tr_b16 %8, %16 offset:4608\n\tds_read_b64_tr_b16 %9, %16 offset:5184\n\tds_read_b64_tr_b16 %10, %16 offset:4640\n\tds_read_b64_tr_b16 %11, %16 offset:5216\n\t"
               "ds_read_b64_tr_b16 %12, %16 offset:4672\n\tds_read_b64_tr_b16 %13, %16 offset:5248\n\tds_read_b64_tr_b16 %14, %16 offset:4704\n\tds_read_b64_tr_b16 %15, %16 offset:5280\n\ts_waitcnt lgkmcnt(0)"
               : "=&v"(t0), "=&v"(t1), "=&v"(t2), "=&v"(t3), "=&v"(t4), "=&v"(t5), "=&v"(t6), "=&v"(t7),
                 "=&v"(u0), "=&v"(u1), "=&v"(u2), "=&v"(u3), "=&v"(u4), "=&v"(u5), "=&v"(u6), "=&v"(u7) : "v"(base) : "memory");
#define TRF(a, b) __builtin_bit_cast(bf16x8, ((u32x4){a.x, a.y, b.x, b.y}))
  f[0][0] = TRF(t0, t1); f[0][1] = TRF(t2, t3); f[0][2] = TRF(t4, t5); f[0][3] = TRF(t6, t7);
  f[1][0] = TRF(u0, u1); f[1][1] = TRF(u2, u3); f[1][2] = TRF(u4, u5); f[1][3] = TRF(u6, u7);
#undef TRF
}
DEVINL void tr_frags_col(const bf16_t* tile, int nb, int fr, int fq, bf16x8 (&f)[2]) {
  const unsigned base = (unsigned)(uintptr_t)((__attribute__((address_space(3))) char*)tile) + (unsigned)(((8 * fq + (fr >> 2)) * 72 + 16 * nb + 4 * (fr & 3)) * 2);
  u32x2 t0, t1, u0, u1;
  asm volatile("ds_read_b64_tr_b16 %0, %4\n\tds_read_b64_tr_b16 %1, %4 offset:576\n\tds_read_b64_tr_b16 %2, %4 offset:4608\n\tds_read_b64_tr_b16 %3, %4 offset:5184\n\ts_waitcnt lgkmcnt(0)"
               : "=&v"(t0), "=&v"(t1), "=&v"(u0), "=&v"(u1) : "v"(base) : "memory");
  f[0] = __builtin_bit_cast(bf16x8, ((u32x4){t0.x, t0.y, t1.x, t1.y}));
  f[1] = __builtin_bit_cast(bf16x8, ((u32x4){u0.x, u0.y, u1.x, u1.y}));
}
DEVINL void tr_frags_64x128(const bf16_t* tile, int kk, int fr, int fq, bf16x8 (&f)[8]) {
  const unsigned base = (unsigned)(uintptr_t)((__attribute__((address_space(3))) char*)tile) + (unsigned)(((32 * kk + 8 * fq + (fr >> 2)) * 136 + 4 * (fr & 3)) * 2);
  u32x2 t0, t1, t2, t3, t4, t5, t6, t7, u0, u1, u2, u3, u4, u5, u6, u7;
  asm volatile("ds_read_b64_tr_b16 %0, %16\n\tds_read_b64_tr_b16 %1, %16 offset:32\n\tds_read_b64_tr_b16 %2, %16 offset:64\n\tds_read_b64_tr_b16 %3, %16 offset:96\n\t"
               "ds_read_b64_tr_b16 %4, %16 offset:128\n\tds_read_b64_tr_b16 %5, %16 offset:160\n\tds_read_b64_tr_b16 %6, %16 offset:192\n\tds_read_b64_tr_b16 %7, %16 offset:224\n\t"
               "ds_read_b64_tr_b16 %8, %16 offset:1088\n\tds_read_b64_tr_b16 %9, %16 offset:1120\n\tds_read_b64_tr_b16 %10, %16 offset:1152\n\tds_read_b64_tr_b16 %11, %16 offset:1184\n\t"
               "ds_read_b64_tr_b16 %12, %16 offset:1216\n\tds_read_b64_tr_b16 %13, %16 offset:1248\n\tds_read_b64_tr_b16 %14, %16 offset:1280\n\tds_read_b64_tr_b16 %15, %16 offset:1312\n\ts_waitcnt lgkmcnt(0)"
               : "=&v"(t0), "=&v"(t1), "=&v"(t2), "=&v"(t3), "=&v"(t4), "=&v"(t5), "=&v"(t6), "=&v"(t7),
                 "=&v"(u0), "=&v"(u1), "=&v"(u2), "=&v"(u3), "=&v"(u4), "=&v"(u5), "=&v"(u6), "=&v"(u7) : "v"(base) : "memory");
#define TRF(a, b) __builtin_bit_cast(bf16x8, ((u32x4){a.x, a.y, b.x, b.y}))
  f[0] = TRF(t0, u0); f[1] = TRF(t1, u1); f[2] = TRF(t2, u2); f[3] = TRF(t3, u3); f[4] = TRF(t4, u4); f[5] = TRF(t5, u5); f[6] = TRF(t6, u6); f[7] = TRF(t7, u7);
#undef TRF
}
DEVINL void phase_attn(const Params& p, int bid, int nb, char* smem) {
  const int tid = my_tid(), lane = tid & 63, wid = tid >> 6, fr = lane & 15, fq = lane >> 4;
  bf16_t* sK = (bf16_t*)smem;
  bf16_t* sVt = sK + 64 * 72;
  bf16_t* sLh = sVt + 64 * 72 + wid * (3 * 16 * 72);
  bf16_t* sLl = sLh + 16 * 72;
  bf16_t* sW = sLl + 16 * 72;
  int* sFlag = (int*)(smem + 46080);
  const bf16_t* P0 = (const bf16_t*)(p.ws + OFF_PROJ0);
  bf16_t* MIX = (bf16_t*)(p.ws + OFF_MIX);
  bf16x8 tri[6];
  {
    const int combos[6][2] = {{0, 0}, {0, 1}, {1, 0}, {1, 1}, {2, 1}, {3, 1}};
#pragma unroll
    for (int c = 0; c < 6; ++c)
#pragma unroll
      for (int e = 0; e < 8; ++e) tri[c][e] = (combos[c][1] * 32 + fq * 8 + e >= combos[c][0] * 16 + fr) ? (short)0x3F80 : (short)0;
  }
  int* sTask = sFlag + 4;
  unsigned* q = (unsigned*)(p.ws + OFF_CTL) + CTL_ATTQ;
  if (tid == 0) sTask[0] = (int)atomicAdd(q, 1u);
  hsync();
  int task = sTask[0];
  while (task < 4096) {
    hsync();
    if (tid == 0) sTask[0] = (int)atomicAdd(q, 1u);
    const int bh = task & 63, qt = 63 - (task >> 6);
    const int b = bh >> 3, h = bh & 7;
    const int tq = qt * 64 + wid * 16 + fr;
    bf16x8 qf[2];
#pragma unroll
    for (int kk = 0; kk < 2; ++kk) {
      float q[8];
      ld8bf(P0 + ((size_t)b * SEQ + tq) * 2048 + 512 + h * 64 + kk * 32 + fq * 8, q);
#pragma unroll
      for (int e = 0; e < 8; ++e) qf[kk][e] = (short)f2bf(q[e] * 0.125f);
    }
    f32x4 o[4];
#pragma unroll
    for (int dt = 0; dt < 4; ++dt) o[dt] = (f32x4){0.f, 0.f, 0.f, 0.f};
    float R = 0.f;
    u32x4 gk[2], gv[2];
#pragma unroll
    for (int i = 0; i < 2; ++i) {
      const int id = tid + 256 * i, s_ = id >> 3, d0 = (id & 7) * 8;
      const bf16_t* src = P0 + ((size_t)b * SEQ + qt * 64 + s_) * 2048 + 1024 + h * 64 + d0;
      gk[i] = *(const u32x4*)src; gv[i] = *(const u32x4*)(src + 512);
    }
    for (int kb = qt; kb >= 0; --kb) {
#pragma unroll
      for (int i = 0; i < 2; ++i) {
        const int id = tid + 256 * i, s_ = id >> 3, d0 = (id & 7) * 8;
        *(u32x4*)(sK + s_ * 72 + d0) = gk[i];
        *(u32x4*)(sVt + s_ * 72 + d0) = gv[i];
      }
      if (kb > 0) {
#pragma unroll
        for (int i = 0; i < 2; ++i) {
          const int id = tid + 256 * i, s_ = id >> 3, d0 = (id & 7) * 8;
          const bf16_t* src = P0 + ((size_t)b * SEQ + (kb - 1) * 64 + s_) * 2048 + 1024 + h * 64 + d0;
          gk[i] = *(const u32x4*)src; gv[i] = *(const u32x4*)(src + 512);
        }
      }
      hsync();
      f32x4 z[4];
#pragma unroll
      for (int nt = 0; nt < 4; ++nt) z[nt] = (f32x4){0.f, 0.f, 0.f, 0.f};
#pragma unroll
      for (int kk = 0; kk < 2; ++kk)
#pragma unroll
        for (int nt = 0; nt < 4; ++nt) {
          const bf16x8 kf = *(const bf16x8*)(sK + (nt * 16 + fr) * 72 + kk * 32 + fq * 8);
          z[nt] = __builtin_amdgcn_mfma_f32_16x16x32_bf16(kf, qf[kk], z[nt], 0, 0, 0);
        }
      const bool diag = (kb == qt);
#pragma unroll
      for (int nt = 0; nt < 4; ++nt) {
        float zz[4] = {z[nt].x, z[nt].y, z[nt].z, z[nt].w}, lk[4], hi[4], lo[4];
#pragma unroll
        for (int j = 0; j < 4; ++j) {
          const int sg = kb * 64 + nt * 16 + fq * 4 + j;
          const bool valid = !diag || (sg < tq);
          lk[j] = valid ? -(fmaxf(zz[j], 0.f) + __logf(1.f + __expf(-fabsf(zz[j])))) : 0.f;
          hi[j] = bf2f(f2bf(lk[j]));
          lo[j] = lk[j] - hi[j];
        }
        st4bf(sLh + fr * 72 + nt * 16 + fq * 4, hi[0], hi[1], hi[2], hi[3]);
        st4bf(sLl + fr * 72 + nt * 16 + fq * 4, lo[0], lo[1], lo[2], lo[3]);
      }
      __builtin_amdgcn_wave_barrier();
      f32x4 sf[4];
#pragma unroll
      for (int nt = 0; nt < 4; ++nt) sf[nt] = (f32x4){R, R, R, R};
      {
        const bf16x8 lh0 = *(const bf16x8*)(sLh + fr * 72 + fq * 8), lh1 = *(const bf16x8*)(sLh + fr * 72 + 32 + fq * 8);
        const bf16x8 ll0 = *(const bf16x8*)(sLl + fr * 72 + fq * 8), ll1 = *(const bf16x8*)(sLl + fr * 72 + 32 + fq * 8);
        sf[0] = __builtin_amdgcn_mfma_f32_16x16x32_bf16(tri[0], lh0, sf[0], 0, 0, 0);
        sf[0] = __builtin_amdgcn_mfma_f32_16x16x32_bf16(tri[0], ll0, sf[0], 0, 0, 0);
        sf[0] = __builtin_amdgcn_mfma_f32_16x16x32_bf16(tri[1], lh1, sf[0], 0, 0, 0);
        sf[0] = __builtin_amdgcn_mfma_f32_16x16x32_bf16(tri[1], ll1, sf[0], 0, 0, 0);
        sf[1] = __builtin_amdgcn_mfma_f32_16x16x32_bf16(tri[2], lh0, sf[1], 0, 0, 0);
        sf[1] = __builtin_amdgcn_mfma_f32_16x16x32_bf16(tri[2], ll0, sf[1], 0, 0, 0);
        sf[1] = __builtin_amdgcn_mfma_f32_16x16x32_bf16(tri[3], lh1, sf[1], 0, 0, 0);
        sf[1] = __builtin_amdgcn_mfma_f32_16x16x32_bf16(tri[3], ll1, sf[1], 0, 0, 0);
        sf[2] = __builtin_amdgcn_mfma_f32_16x16x32_bf16(tri[4], lh1, sf[2], 0, 0, 0);
        sf[2] = __builtin_amdgcn_mfma_f32_16x16x32_bf16(tri[4], ll1, sf[2], 0, 0, 0);
        sf[3] = __builtin_amdgcn_mfma_f32_16x16x32_bf16(tri[5], lh1, sf[3], 0, 0, 0);
        sf[3] = __builtin_amdgcn_mfma_f32_16x16x32_bf16(tri[5], ll1, sf[3], 0, 0, 0);
      }
#pragma unroll
      for (int nt = 0; nt < 4; ++nt) {
        const float zz[4] = {z[nt].x, z[nt].y, z[nt].z, z[nt].w}, ss[4] = {sf[nt].x, sf[nt].y, sf[nt].z, sf[nt].w};
        float w[4];
#pragma unroll
        for (int j = 0; j < 4; ++j) {
          const int sg = kb * 64 + nt * 16 + fq * 4 + j;
          const bool valid = !diag || (sg < tq);
          w[j] = valid ? __expf(zz[j] + ss[j]) : 0.f;
        }
        st4bf(sW + fr * 72 + nt * 16 + fq * 4, w[0], w[1], w[2], w[3]);
      }
      R = __shfl(sf[0].x, fr);
      __builtin_amdgcn_wave_barrier();
      {
        const unsigned vbase = (unsigned)(uintptr_t)((__attribute__((address_space(3))) char*)sVt) + (unsigned)(((8 * fq + (fr >> 2)) * 72 + 4 * (fr & 3)) * 2);
        const bf16x8 wf0 = *(const bf16x8*)(sW + fr * 72 + fq * 8), wf1 = *(const bf16x8*)(sW + fr * 72 + 32 + fq * 8);
        u32x2 t0, t1, t2, t3, t4, t5, t6, t7, u0, u1, u2, u3, u4, u5, u6, u7;
        asm volatile("ds_read_b64_tr_b16 %0, %16\n\tds_read_b64_tr_b16 %1, %16 offset:576\n\tds_read_b64_tr_b16 %2, %16 offset:32\n\tds_read_b64_tr_b16 %3, %16 offset:608\n\t"
                     "ds_read_b64_tr_b16 %4, %16 offset:64\n\tds_read_b64_tr_b16 %5, %16 offset:640\n\tds_read_b64_tr_b16 %6, %16 offset:96\n\tds_read_b64_tr_b16 %7, %16 offset:672\n\t"
                     "ds_read_b64_tr_b16 %8, %16 offset:4608\n\tds_read_b64_tr_b16 %9, %16 offset:5184\n\tds_read_b64_tr_b16 %10, %16 offset:4640\n\tds_read_b64_tr_b16 %11, %16 offset:5216\n\t"
                     "ds_read_b64_tr_b16 %12, %16 offset:4672\n\tds_read_b64_tr_b16 %13, %16 offset:5248\n\tds_read_b64_tr_b16 %14, %16 offset:4704\n\tds_read_b64_tr_b16 %15, %16 offset:5280\n\ts_waitcnt lgkmcnt(0)"
                     : "=&v"(t0), "=&v"(t1), "=&v"(t2), "=&v"(t3), "=&v"(t4), "=&v"(t5), "=&v"(t6), "=&v"(t7),
                       "=&v"(u0), "=&v"(u1), "=&v"(u2), "=&v"(u3), "=&v"(u4), "=&v"(u5), "=&v"(u6), "=&v"(u7) : "v"(vbase) : "memory");
#define ATT_PV(dt, a, b, wf) o[dt] = __builtin_amdgcn_mfma_f32_16x16x32_bf16(__builtin_bit_cast(bf16x8, ((u32x4){a.x, a.y, b.x, b.y})), wf, o[dt], 0, 0, 0)
        ATT_PV(0, t0, t1, wf0); ATT_PV(1, t2, t3, wf0); ATT_PV(2, t4, t5, wf0); ATT_PV(3, t6, t7, wf0);
        ATT_PV(0, u0, u1, wf1); ATT_PV(1, u2, u3, wf1); ATT_PV(2, u4, u5, wf1); ATT_PV(3, u6, u7, wf1);
#undef ATT_PV
      }
      const int done = __all(R < -104.f);
      if (lane == 0) sFlag[wid] = done;
      hsync();
      if (sFlag[0] && sFlag[1] && sFlag[2] && sFlag[3]) break;
    }
#pragma unroll
    for (int dt = 0; dt < 4; ++dt)
      st4bf(MIX + ((size_t)b * SEQ + tq) * 1024 + 512 + h * 64 + dt * 16 + fq * 4, o[dt].x, o[dt].y, o[dt].z, o[dt].w);
    hsync();
    task = sTask[0];
  }
}

DEVINL void phase_rwkv_pre(const Params& p, int bid, int nb, char* smem) {
  const int tid = my_tid(), lane = tid & 63, wid = tid >> 6;
  const bf16_t* PR = (const bf16_t*)(p.ws + OFF_PROJR);
  bf16_t* KP = (bf16_t*)(p.ws + OFF_RKP);
  bf16_t* KK = (bf16_t*)(p.ws + OFF_RKK);
  bf16_t* LW = (bf16_t*)(p.ws + OFF_LORAW);
  bf16_t* LA = (bf16_t*)(p.ws + OFF_LORAA);
  bf16_t* LG = (bf16_t*)(p.ws + OFF_LORAG);
  const float* mu = p.in[I_RW_MU];
  float mu_k[8], wkk[8], mu_l[8];
  const int ck = lane * 8, cl = (lane & 31) * 8;
#pragma unroll
  for (int j = 0; j < 8; ++j) { mu_k[j] = mu[512 + ck + j]; wkk[j] = p.in[I_RW_KK][ck + j]; mu_l[j] = mu[1536 + cl + j]; }
  const int nwaves = nb * 4;
  for (int pr = bid * 4 + wid; pr < T / 2; pr += nwaves) {
    const int rowA = pr * 2, rowL = pr * 2 + (lane >> 5);
    const bool firstA = (rowA & (SEQ - 1)) == 0, firstL = (rowL & (SEQ - 1)) == 0;
    u32x4 rk[3], rl[2];
    rk[0] = firstA ? (u32x4){0u, 0u, 0u, 0u} : *(const u32x4*)(PR + (size_t)(rowA - 1) * 1792 + 512 + ck);
    rk[1] = *(const u32x4*)(PR + (size_t)rowA * 1792 + 512 + ck);
    rk[2] = *(const u32x4*)(PR + (size_t)(rowA + 1) * 1792 + 512 + ck);
    rl[0] = firstL ? (u32x4){0u, 0u, 0u, 0u} : *(const u32x4*)(PR + (size_t)(rowL - 1) * 1792 + 1536 + cl);
    rl[1] = *(const u32x4*)(PR + (size_t)rowL * 1792 + 1536 + cl);
#pragma unroll
    for (int tk = 0; tk < 2; ++tk) {
      const int row = pr * 2 + tk;
      const u32x4 cv = rk[tk + 1], qv = rk[tk];
      const float c[8] = {lo2f(cv.x), hi2f(cv.x), lo2f(cv.y), hi2f(cv.y), lo2f(cv.z), hi2f(cv.z), lo2f(cv.w), hi2f(cv.w)};
      const float q[8] = {lo2f(qv.x), hi2f(qv.x), lo2f(qv.y), hi2f(qv.y), lo2f(qv.z), hi2f(qv.z), lo2f(qv.w), hi2f(qv.w)};
      float km[8], kv[8], ss = 0.f;
#pragma unroll
      for (int j = 0; j < 8; ++j) { km[j] = c[j] + (q[j] - c[j]) * mu_k[j]; kv[j] = km[j] * wkk[j]; ss += kv[j] * kv[j]; }
      ss += __shfl_xor(ss, 1); ss += __shfl_xor(ss, 2); ss += __shfl_xor(ss, 4);
      const float inv = 1.f / fmaxf(sqrtf(ss), 1e-12f);
      u32x4 o;
      o.x = pk2(km[0], km[1]); o.y = pk2(km[2], km[3]); o.z = pk2(km[4], km[5]); o.w = pk2(km[6], km[7]);
      *(u32x4*)(KP + (size_t)row * 512 + ck) = o;
      o.x = pk2(kv[0] * inv, kv[1] * inv); o.y = pk2(kv[2] * inv, kv[3] * inv); o.z = pk2(kv[4] * inv, kv[5] * inv); o.w = pk2(kv[6] * inv, kv[7] * inv);
      *(u32x4*)(KK + (size_t)row * 512 + ck) = o;
    }
    {
      const int row = rowL, l5 = lane & 31;
      const float c[8] = {lo2f(rl[1].x), hi2f(rl[1].x), lo2f(rl[1].y), hi2f(rl[1].y), lo2f(rl[1].z), hi2f(rl[1].z), lo2f(rl[1].w), hi2f(rl[1].w)};
      const float q[8] = {lo2f(rl[0].x), hi2f(rl[0].x), lo2f(rl[0].y), hi2f(rl[0].y), lo2f(rl[0].z), hi2f(rl[0].z), lo2f(rl[0].w), hi2f(rl[0].w)};
      float m[8];
#pragma unroll
      for (int j = 0; j < 8; ++j) {
        const float x = c[j] + (q[j] - c[j]) * mu_l[j];
        m[j] = (l5 < 8) ? tanh_(x) : (l5 < 16) ? x : sigmoid_(x);
      }
      u32x4 o;
      o.x = pk2(m[0], m[1]); o.y = pk2(m[2], m[3]); o.z = pk2(m[4], m[5]); o.w = pk2(m[6], m[7]);
      bf16_t* dst = (l5 < 8) ? (LW + (size_t)row * 64 + l5 * 8) : (l5 < 16) ? (LA + (size_t)row * 64 + (l5 - 8) * 8) : (LG + (size_t)row * 128 + (l5 - 16) * 8);
      *(u32x4*)dst = o;
    }
  }
}
DEVINL void phase_rwkv_lora(const Params& p, int bid, int nb, int which, char* smem) {
  TILE_IDS
  const int K = (which == 2) ? 128 : 64;
  const bf16_t* A = (const bf16_t*)(p.ws + (which == 0 ? OFF_LORAW : which == 1 ? OFF_LORAA : OFF_LORAG));
  const bf16_t* B = (const bf16_t*)(p.ws + (which == 0 ? OFF_W2T : which == 1 ? OFF_A2T : OFF_G2T));
  bf16_t* WE = (bf16_t*)(p.ws + OFF_RWE);
  bf16_t* RA = (bf16_t*)(p.ws + OFF_RA);
  bf16_t* KP = (bf16_t*)(p.ws + OFF_RKP);
  for (int tile = bid; tile < 256 * 4; tile += nb) {
    const int mt = tile >> 2, nt = tile & 3;
    ROWS4(ap, A, mt * 128, K);
    ROWS4(bp, B, nt * 128, K);
    f32x4 acc[4][4]; acc_zero(acc);
    gemm_core(acc, ap, 64, bp, 64, K / 64, smem);
    if (which == 0) {
#pragma unroll
      for (int n = 0; n < 4; ++n) {
        const int col = nt * 128 + wc * 64 + n * 16 + fq * 4;
        const f32x4 w0 = *(const f32x4*)(p.in[I_RW_W0] + col);
#pragma unroll
        for (int m = 0; m < 4; ++m) {
          const int row = mt * 128 + wr * 64 + m * 16 + fr;
          const f32x4 a = acc[m][n];
          st4bf(WE + (size_t)row * 512 + col, __expf(-softplus_(-(w0.x + a.x)) - 0.5f), __expf(-softplus_(-(w0.y + a.y)) - 0.5f),
                __expf(-softplus_(-(w0.z + a.z)) - 0.5f), __expf(-softplus_(-(w0.w + a.w)) - 0.5f));
        }
      }
    } else if (which == 1) {
#pragma unroll
      for (int n = 0; n < 4; ++n) {
        const int col = nt * 128 + wc * 64 + n * 16 + fq * 4;
        const f32x4 a0 = *(const f32x4*)(p.in[I_RW_A0] + col), ka = *(const f32x4*)(p.in[I_RW_KA] + col);
#pragma unroll
        for (int m = 0; m < 4; ++m) {
          const int row = mt * 128 + wr * 64 + m * 16 + fr;
          float km[4];
          ld4bf(KP + (size_t)row * 512 + col, km);
          const float s0 = sigmoid_(a0.x + acc[m][n].x), s1 = sigmoid_(a0.y + acc[m][n].y), s2 = sigmoid_(a0.z + acc[m][n].z), s3 = sigmoid_(a0.w + acc[m][n].w);
          st4bf(RA + (size_t)row * 512 + col, s0, s1, s2, s3);
          st4bf(KP + (size_t)row * 512 + col, km[0] * (1.f + (s0 - 1.f) * ka.x), km[1] * (1.f + (s1 - 1.f) * ka.y), km[2] * (1.f + (s2 - 1.f) * ka.z), km[3] * (1.f + (s3 - 1.f) * ka.w));
        }
      }
    } else {
      const bf16_t* PR = (const bf16_t*)(p.ws + OFF_PROJR);
      bf16_t* MIX = (bf16_t*)(p.ws + OFF_MIX);
      const bf16_t* YR = (const bf16_t*)(p.ws + OFF_RA);
      const float* mu = p.in[I_RW_MU];
#pragma unroll
      for (int m = 0; m < 4; ++m) {
        const int row = mt * 128 + wr * 64 + m * 16 + fr;
        const bool first = (row & (SEQ - 1)) == 0;
        float sy = 0.f, sy2 = 0.f, sb = 0.f;
#pragma unroll
        for (int n = 0; n < 4; ++n) {
          const int col = nt * 128 + wc * 64 + n * 16 + fq * 4;
          const f32x4 mu4 = *(const f32x4*)(mu + col), rk4 = *(const f32x4*)(p.in[I_RW_RK] + col);
          const float mu_[4] = {mu4.x, mu4.y, mu4.z, mu4.w}, rk_[4] = {rk4.x, rk4.y, rk4.z, rk4.w};
          float y[4], kq[4], rc[4], rp[4] = {0.f, 0.f, 0.f, 0.f};
          ld4bf(YR + (size_t)row * 512 + col, y);
          ld4bf(KP + (size_t)row * 512 + col, kq);
          ld4bf(PR + (size_t)row * 1792 + col, rc);
          if (!first) ld4bf(PR + (size_t)(row - 1) * 1792 + col, rp);
#pragma unroll
          for (int j = 0; j < 4; ++j) {
            const float rm = rc[j] + (rp[j] - rc[j]) * mu_[j];
            sy += y[j]; sy2 += y[j] * y[j];
            sb += rm * kq[j] * rk_[j];
          }
        }
        sy += __shfl_xor(sy, 16); sy += __shfl_xor(sy, 32);
        sy2 += __shfl_xor(sy2, 16); sy2 += __shfl_xor(sy2, 32);
        sb += __shfl_xor(sb, 16); sb += __shfl_xor(sb, 32);
        const float mean = sy * (1.f / 64.f);
        const float var = fmaxf(sy2 * (1.f / 64.f) - mean * mean, 0.f);
        const float rstd = rsqrtf(var + 64e-5f);
#pragma unroll
        for (int n = 0; n < 4; ++n) {
          const int col = nt * 128 + wc * 64 + n * 16 + fq * 4;
          const f32x4 mv4 = *(const f32x4*)(mu + 1024 + col), lw4 = *(const f32x4*)(p.in[I_RW_LNW] + col), lb4 = *(const f32x4*)(p.in[I_RW_LNB] + col);
          const float mv_[4] = {mv4.x, mv4.y, mv4.z, mv4.w}, lw_[4] = {lw4.x, lw4.y, lw4.z, lw4.w}, lb_[4] = {lb4.x, lb4.y, lb4.z, lb4.w};
          float y[4], vc[4], vp[4] = {0.f, 0.f, 0.f, 0.f};
          ld4bf(YR + (size_t)row * 512 + col, y);
          ld4bf(PR + (size_t)row * 1792 + 1024 + col, vc);
          if (!first) ld4bf(PR + (size_t)(row - 1) * 1792 + 1024 + col, vp);
          const float g4[4] = {acc[m][n].x, acc[m][n].y, acc[m][n].z, acc[m][n].w};
          float o[4];
#pragma unroll
          for (int j = 0; j < 4; ++j) {
            const float vm = vc[j] + (vp[j] - vc[j]) * mv_[j];
            o[j] = ((y[j] - mean) * rstd * lw_[j] + lb_[j] + sb * vm) * g4[j];
          }
          st4bf(MIX + (size_t)row * 1024 + col, o[0], o[1], o[2], o[3]);
        }
      }
    }
  }
}
DEVINL void phase_m2_pre(const Params& p, int bid, int nb, char* smem) {
  const bf16_t* PM = (const bf16_t*)(p.ws + OFF_PROJM);
  bf16_t* XBC = (bf16_t*)(p.ws + OFF_XBC);
  const float* cw = p.in[I_M2_CONVW];
  const float* cb = p.in[I_M2_CONVB];
  const int c = (my_tid() & 127) * 8, grp = my_tid() >> 7;
  float w[4][8], bias[8];
#pragma unroll
  for (int j = 0; j < 8; ++j) { bias[j] = cb[c + j]; w[0][j] = cw[c + j]; w[1][j] = cw[1024 + c + j]; w[2][j] = cw[2048 + c + j]; w[3][j] = cw[3072 + c + j]; }
  for (int it = bid * 2 + grp; it < T / 16; it += nb * 2) {
    const int row0 = it * 16, t0 = row0 & (SEQ - 1);
    float x0[8], x1[8], x2[8], x3[8];
    if (t0 > 0) {
      ld8bf(PM + (size_t)(row0 - 3) * 1664 + 512 + c, x0);
      ld8bf(PM + (size_t)(row0 - 2) * 1664 + 512 + c, x1);
      ld8bf(PM + (size_t)(row0 - 1) * 1664 + 512 + c, x2);
    } else {
#pragma unroll
      for (int j = 0; j < 8; ++j) { x0[j] = 0.f; x1[j] = 0.f; x2[j] = 0.f; }
    }
    u32x4 raw[16];
#pragma unroll
    for (int tt = 0; tt < 16; ++tt) raw[tt] = *(const u32x4*)(PM + (size_t)(row0 + tt) * 1664 + 512 + c);
#pragma unroll
    for (int tt = 0; tt < 16; ++tt) {
      x3[0] = lo2f(raw[tt].x); x3[1] = hi2f(raw[tt].x); x3[2] = lo2f(raw[tt].y); x3[3] = hi2f(raw[tt].y);
      x3[4] = lo2f(raw[tt].z); x3[5] = hi2f(raw[tt].z); x3[6] = lo2f(raw[tt].w); x3[7] = hi2f(raw[tt].w);
      float o[8];
#pragma unroll
      for (int j = 0; j < 8; ++j) {
        o[j] = silu_(bias[j] + w[0][j] * x0[j] + w[1][j] * x1[j] + w[2][j] * x2[j] + w[3][j] * x3[j]);
        x0[j] = x1[j]; x1[j] = x2[j]; x2[j] = x3[j];
      }
      u32x4 v;
      v.x = pk2(o[0], o[1]); v.y = pk2(o[2], o[3]); v.z = pk2(o[4], o[5]); v.w = pk2(o[6], o[7]);
      *(u32x4*)(XBC + (size_t)(row0 + tt) * 1024 + c) = v;
    }
  }
  const float* DR = (const float*)(p.ws + OFF_DTRAW);
  float* DV = (float*)(p.ws + OFF_DTV);
  for (int i = bid * 256 + my_tid(); i < T * 8; i += nb * 256) DV[i] = softplus_(DR[i] + p.in[I_M2_DTB][i & 7]);
}
DEVINL float wave_incl_scan(float v, int lane) {
#pragma unroll
  for (int o = 1; o < 64; o <<= 1) { float t = __shfl_up(v, o); if (lane >= o) v += t; }
  return v;
}
DEVINL void phase_ssd_a(const Params& p, int bid, int nb, char* smem) {
  const int tid = my_tid(), lane = tid & 63, wid = tid >> 6, fr = lane & 15, fq = lane >> 4;
  bf16_t* sBT = (bf16_t*)smem;
  bf16_t* sXT = sBT + 128 * 72;
  float* sSc = (float*)(sXT + 64 * 72);
  const bf16_t* XBC = (const bf16_t*)(p.ws + OFF_XBC);
  const float* DV = (const float*)(p.ws + OFF_DTV);
  bf16_t* ST = (bf16_t*)(p.ws + OFF_ST);
  float* ATOT = (float*)(p.ws + OFF_ATOT);
  for (int task = bid; task < 1024; task += nb) {
    const int bc = task >> 1, gi = task & 1;
    const size_t row0 = (size_t)bc * 64;
    struct HeadIn { u32x4 xr[2]; float dt; };
    auto load_head = [&](HeadIn& hin, int h) {
#pragma unroll
      for (int i = 0; i < 2; ++i) { const int id = tid + 256 * i, l = id >> 3, p0 = (id & 7) * 8; hin.xr[i] = *(const u32x4*)(XBC + (row0 + l) * 1024 + h * 64 + p0); }
      hin.dt = DV[(row0 + lane) * 8 + h];
    };
    HeadIn cur;
    load_head(cur, gi * 4);
#pragma unroll
    for (int i = 0; i < 4; ++i) {
      const int id = tid + 256 * i, l = id >> 4, n0 = (id & 15) * 8;
      u32x4 v = *(const u32x4*)(XBC + (row0 + l) * 1024 + 512 + gi * 128 + n0);
      *(u32x4*)(sBT + l * 136 + n0) = v;
    }
    for (int hh = 0; hh < 4; ++hh) {
      const int h = gi * 4 + hh;
      const float a = -expf(p.in[I_M2_ALOG][h]);
      const float dt = cur.dt;
      const float acs = wave_incl_scan(a * dt, lane);
      const float tot = __shfl(acs, 63);
      if (wid == 0) { sSc[lane] = dt * expf(tot - acs); if (lane == 63) ATOT[bc * 8 + h] = tot; }
      HeadIn nxt;
      load_head(nxt, (hh < 3) ? h + 1 : h);
      hsync();
#pragma unroll
      for (int i = 0; i < 2; ++i) {
        const int id = tid + 256 * i, l = id >> 3, p0 = (id & 7) * 8;
        const u32x4 xv = cur.xr[i];
        const float x[8] = {lo2f(xv.x), hi2f(xv.x), lo2f(xv.y), hi2f(xv.y), lo2f(xv.z), hi2f(xv.z), lo2f(xv.w), hi2f(xv.w)};
        const float sc = sSc[l];
        u32x4 o;
        o.x = pk2(x[0] * sc, x[1] * sc); o.y = pk2(x[2] * sc, x[3] * sc); o.z = pk2(x[4] * sc, x[5] * sc); o.w = pk2(x[6] * sc, x[7] * sc);
        *(u32x4*)(sXT + l * 72 + p0) = o;
      }
      hsync();
      f32x4 acc[8];
#pragma unroll
      for (int nt = 0; nt < 8; ++nt) acc[nt] = (f32x4){0.f, 0.f, 0.f, 0.f};
      {
        bf16x8 af[2];
        tr_frags_col(sXT, wid, fr, fq, af);
#pragma unroll
        for (int kk = 0; kk < 2; ++kk) {
          bf16x8 bfr[8];
          tr_frags_64x128(sBT, kk, fr, fq, bfr);
#pragma unroll
          for (int nt = 0; nt < 8; ++nt) acc[nt] = __builtin_amdgcn_mfma_f32_16x16x32_bf16(bfr[nt], af[kk], acc[nt], 0, 0, 0);
        }
      }
      bf16_t* dst = ST + ((size_t)bc * 8 + h) * 8192 + (wid * 16 + fr) * 128 + fq * 4;
#pragma unroll
      for (int nt = 0; nt < 8; ++nt) st4bf(dst + nt * 16, acc[nt].x, acc[nt].y, acc[nt].z, acc[nt].w);
      hsync();
      cur = nxt;
    }
  }
}
DEVINL void phase_ssd_b(const Params& p, int bid, int nb, char* smem) {
  bf16_t* ST = (bf16_t*)(p.ws + OFF_ST);
  const float* ATOT = (const float*)(p.ws + OFF_ATOT);
  for (int id = bid * 256 + my_tid(); id < 65536; id += nb * 256) {
    const int n8 = id & 15, pp = (id >> 4) & 63, h = (id >> 10) & 7, b = id >> 13;
    float run[8];
#pragma unroll
    for (int j = 0; j < 8; ++j) run[j] = 0.f;
#pragma unroll 1
    for (int c0 = 0; c0 < 64; c0 += 16) {
      u32x4 raw[16]; float dec[16];
#pragma unroll
      for (int i = 0; i < 16; ++i) {
        raw[i] = *(const u32x4*)(ST + ((size_t)(b * 64 + c0 + i) * 8 + h) * 8192 + pp * 128 + n8 * 8);
        dec[i] = ATOT[(b * 64 + c0 + i) * 8 + h];
      }
#pragma unroll
      for (int i = 0; i < 16; ++i) {
        bf16_t* ptr = ST + ((size_t)(b * 64 + c0 + i) * 8 + h) * 8192 + pp * 128 + n8 * 8;
        u32x4 o; o.x = pk2(run[0], run[1]); o.y = pk2(run[2], run[3]); o.z = pk2(run[4], run[5]); o.w = pk2(run[6], run[7]);
        *(u32x4*)ptr = o;
        const float d = expf(dec[i]);
        const float loc[8] = {lo2f(raw[i].x), hi2f(raw[i].x), lo2f(raw[i].y), hi2f(raw[i].y), lo2f(raw[i].z), hi2f(raw[i].z), lo2f(raw[i].w), hi2f(raw[i].w)};
#pragma unroll
        for (int j = 0; j < 8; ++j) run[j] = d * run[j] + loc[j];
      }
    }
  }
}
DEVINL void phase_ssd_c(const Params& p, int bid, int nb, char* smem) {
  const int tid = my_tid(), lane = tid & 63, wid = tid >> 6, fr = lane & 15, fq = lane >> 4;
  bf16_t* sS = (bf16_t*)smem;
  bf16_t* sM = sS + 64 * 136;
  bf16_t* sX = sM + 64 * 72;
  float* sAcs = (float*)(sX + 64 * 72);
  float* sDt = sAcs + 64;
  const bf16_t* XBC = (const bf16_t*)(p.ws + OFF_XBC);
  const bf16_t* PM = (const bf16_t*)(p.ws + OFF_PROJM);
  const float* DV = (const float*)(p.ws + OFF_DTV);
  const bf16_t* ST = (const bf16_t*)(p.ws + OFF_ST);
  bf16_t* MIX = (bf16_t*)(p.ws + OFF_MIX);
  unsigned* q = (unsigned*)(p.ws + OFF_CTL) + CTL_SSDQ;
  int* sQ = (int*)(smem + 65536 + 64 + 176);
  for (;;) {
    hsync();
    if (tid == 0) sQ[0] = (int)atomicAdd(q, 1u);
    hsync();
    const int task = sQ[0];
    if (task >= 1024) break;
    const int bc = task >> 1, gi = task & 1;
    const size_t row0 = (size_t)bc * 64;
    const int l = wid * 16 + fr;
    struct HeadIn { u32x4 st[4]; u32x4 xr[2]; float dt; };
    auto load_head = [&](HeadIn& hin, int h) {
      const bf16_t* src = ST + ((size_t)bc * 8 + h) * 8192;
#pragma unroll
      for (int i = 0; i < 4; ++i) { const int id = tid + 256 * i, pp = id >> 4, n0 = (id & 15) * 8; hin.st[i] = *(const u32x4*)(src + pp * 128 + n0); }
#pragma unroll
      for (int i = 0; i < 2; ++i) { const int id = tid + 256 * i, s_ = id >> 3, p0 = (id & 7) * 8; hin.xr[i] = *(const u32x4*)(XBC + (row0 + s_) * 1024 + h * 64 + p0); }
      hin.dt = DV[(row0 + lane) * 8 + h];
    };
    HeadIn cur;
    load_head(cur, gi * 4);
    bf16x8 cf[4];
#pragma unroll
    for (int kk = 0; kk < 4; ++kk) cf[kk] = *(const bf16x8*)(XBC + (row0 + l) * 1024 + 768 + gi * 128 + kk * 32 + fq * 8);
    f32x4 G[4];
#pragma unroll
    for (int nt = 0; nt < 4; ++nt) G[nt] = (f32x4){0.f, 0.f, 0.f, 0.f};
#pragma unroll
    for (int kk = 0; kk < 4; ++kk)
#pragma unroll
      for (int nt = 0; nt < 4; ++nt) {
        const bf16x8 bf = *(const bf16x8*)(XBC + (row0 + nt * 16 + fr) * 1024 + 512 + gi * 128 + kk * 32 + fq * 8);
        G[nt] = __builtin_amdgcn_mfma_f32_16x16x32_bf16(bf, cf[kk], G[nt], 0, 0, 0);
      }
    float ss = 0.f;
#pragma unroll 1
    for (int hh = 0; hh < 4; ++hh) {
      const int h = gi * 4 + hh;
      const float a = -expf(p.in[I_M2_ALOG][h]);
      const float Dh = p.in[I_M2_D][h];
      const float dt = cur.dt;
      const float acs = wave_incl_scan(a * dt, lane);
      if (wid == 0) { sAcs[lane] = acs; sDt[lane] = dt; }
#pragma unroll
      for (int i = 0; i < 4; ++i) { const int id = tid + 256 * i, pp = id >> 4, n0 = (id & 15) * 8; *(u32x4*)(sS + pp * 136 + n0) = cur.st[i]; }
      hsync();
#pragma unroll
      for (int i = 0; i < 2; ++i) {
        const int id = tid + 256 * i, s_ = id >> 3, p0 = (id & 7) * 8;
        const u32x4 xv = cur.xr[i];
        const float x[8] = {lo2f(xv.x), hi2f(xv.x), lo2f(xv.y), hi2f(xv.y), lo2f(xv.z), hi2f(xv.z), lo2f(xv.w), hi2f(xv.w)};
        const float d = sDt[s_];
        u32x4 o;
        o.x = pk2(x[0] * d, x[1] * d); o.y = pk2(x[2] * d, x[3] * d); o.z = pk2(x[4] * d, x[5] * d); o.w = pk2(x[6] * d, x[7] * d);
        *(u32x4*)(sX + s_ * 72 + p0) = o;
      }
      {
        const float al = sAcs[l];
#pragma unroll
        for (int nt = 0; nt < 4; ++nt) {
          float m[4];
          const float g4[4] = {G[nt].x, G[nt].y, G[nt].z, G[nt].w};
#pragma unroll
          for (int j = 0; j < 4; ++j) {
            const int s_ = nt * 16 + fq * 4 + j;
            m[j] = (s_ <= l) ? g4[j] * __expf(al - sAcs[s_]) : 0.f;
          }
          st4bf(sM + l * 72 + nt * 16 + fq * 4, m[0], m[1], m[2], m[3]);
        }
      }
      HeadIn nxt;
      load_head(nxt, (hh < 3) ? h + 1 : h);
      u32x2 ex[4], ez[4];
#pragma unroll
      for (int pt = 0; pt < 4; ++pt) {
        ex[pt] = *(const u32x2*)(XBC + (row0 + l) * 1024 + h * 64 + pt * 16 + fq * 4);
        ez[pt] = *(const u32x2*)(PM + (row0 + l) * 1664 + h * 64 + pt * 16 + fq * 4);
      }
      hsync();
      f32x4 acc[4];
#pragma unroll
      for (int pt = 0; pt < 4; ++pt) acc[pt] = (f32x4){0.f, 0.f, 0.f, 0.f};
#pragma unroll
      for (int kk = 0; kk < 4; ++kk)
#pragma unroll
        for (int pt = 0; pt < 4; ++pt) {
          const bf16x8 sf = *(const bf16x8*)(sS + (pt * 16 + fr) * 136 + kk * 32 + fq * 8);
          acc[pt] = __builtin_amdgcn_mfma_f32_16x16x32_bf16(sf, cf[kk], acc[pt], 0, 0, 0);
        }
      const float ea = expf(sAcs[l]);
#pragma unroll
      for (int pt = 0; pt < 4; ++pt) { acc[pt].x *= ea; acc[pt].y *= ea; acc[pt].z *= ea; acc[pt].w *= ea; }
      {
        bf16x8 xfr[2][4];
        tr_frags_64x64(sX, fr, fq, xfr);
#pragma unroll
        for (int kk = 0; kk < 2; ++kk) {
          const bf16x8 mf = *(const bf16x8*)(sM + l * 72 + kk * 32 + fq * 8);
#pragma unroll
          for (int pt = 0; pt < 4; ++pt) acc[pt] = __builtin_amdgcn_mfma_f32_16x16x32_bf16(xfr[kk][pt], mf, acc[pt], 0, 0, 0);
        }
      }
#pragma unroll
      for (int pt = 0; pt < 4; ++pt) {
        const int c = h * 64 + pt * 16 + fq * 4;
        const float x[4] = {lo2f(ex[pt].x), hi2f(ex[pt].x), lo2f(ex[pt].y), hi2f(ex[pt].y)};
        const float z[4] = {lo2f(ez[pt].x), hi2f(ez[pt].x), lo2f(ez[pt].y), hi2f(ez[pt].y)};
        const float y0 = (acc[pt].x + Dh * x[0]) * silu_(z[0]);
        const float y1 = (acc[pt].y + Dh * x[1]) * silu_(z[1]);
        const float y2 = (acc[pt].z + Dh * x[2]) * silu_(z[2]);
        const float y3 = (acc[pt].w + Dh * x[3]) * silu_(z[3]);
        ss += y0 * y0 + y1 * y1 + y2 * y2 + y3 * y3;
        st4bf(MIX + (row0 + l) * 1024 + 512 + c, y0, y1, y2, y3);
      }
      hsync();
      cur = nxt;
    }
    ss += __shfl_xor(ss, 16); ss += __shfl_xor(ss, 32);
    const float rstd = rsqrtf(ss * (1.f / 256.f) + 1e-6f);
#pragma unroll 1
    for (int hh = 0; hh < 4; ++hh)
#pragma unroll
      for (int pt = 0; pt < 4; ++pt) {
        const int c = (gi * 4 + hh) * 64 + pt * 16 + fq * 4;
        const float* nw = p.in[I_M2_NORMW] + c;
        float yv[4];
        ld4bf(MIX + (row0 + l) * 1024 + 512 + c, yv);
        st4bf(MIX + (row0 + l) * 1024 + 512 + c, yv[0] * rstd * nw[0], yv[1] * rstd * nw[1], yv[2] * rstd * nw[2], yv[3] * rstd * nw[3]);
      }
  }
}

#define RW_FRAG(T, row, kk) (*(const bf16x8*)((T) + (row) * 72 + (kk) * 32 + fq * 8))
#define RW_MMA(acc, nf, mf) acc = __builtin_amdgcn_mfma_f32_16x16x32_bf16(nf, mf, acc, 0, 0, 0)
DEVINL void phase_rwkv_chunk_a(const Params& p, int bid, int nb, char* smem) {
  const int tid = my_tid(), lane = tid & 63, wid = tid >> 6, fr = lane & 15, fq = lane >> 4;
  bf16_t* R0 = (bf16_t*)smem;
  bf16_t* R1 = R0 + 64 * 72;
  bf16_t* R2 = R1 + 64 * 72;
  bf16_t* R3 = R2 + 64 * 72;
  bf16_t* R4 = R3 + 64 * 72;
  bf16_t* R6 = R4 + 2 * 64 * 72;
  float* sL = (float*)R4;
  int* sQ = (int*)(smem + 65536 + 64 + 176);
  const bf16_t* PR = (const bf16_t*)(p.ws + OFF_PROJR);
  bf16_t* KK = (bf16_t*)(p.ws + OFF_RKK);
  bf16_t* RA = (bf16_t*)(p.ws + OFF_RA);
  bf16_t* WE = (bf16_t*)(p.ws + OFF_RWE);
  const bf16_t* KP = (const bf16_t*)(p.ws + OFF_RKP);
  bf16_t* MIX = (bf16_t*)(p.ws + OFF_MIX);
  float* LAM = (float*)(p.ws + OFF_LAM);
  const float* mu = p.in[I_RW_MU];
  unsigned* q = (unsigned*)(p.ws + OFF_CTL) + CTL_RWAQ;
  const int et = tid >> 2, ec = (tid & 3) * 16;
  for (;;) {
    hsync();
    if (tid == 0) sQ[0] = (int)atomicAdd(q, 1u);
    hsync();
    const int task = sQ[0];
    if (task >= 4096) break;
    const int c = task & 63, h = (task >> 6) & 7, b = task >> 9;
    const size_t row0 = (size_t)b * SEQ + c * 64;
    const size_t row = row0 + et;
    const int col = h * 64 + ec;
    u32x4 rw[2][7];
    {
      const bool hasp = (c * 64 + et > 0);
#pragma unroll
      for (int g8 = 0; g8 < 2; ++g8) {
        const int cg = col + g8 * 8;
        rw[g8][0] = *(const u32x4*)(KK + row * 512 + cg);
        rw[g8][1] = *(const u32x4*)(RA + row * 512 + cg);
        rw[g8][2] = *(const u32x4*)(KP + row * 512 + cg);
        rw[g8][3] = *(const u32x4*)(PR + row * 1792 + cg);
        rw[g8][4] = *(const u32x4*)(PR + row * 1792 + 1024 + cg);
        rw[g8][5] = hasp ? *(const u32x4*)(PR + (row - 1) * 1792 + cg) : (u32x4){0u, 0u, 0u, 0u};
        rw[g8][6] = hasp ? *(const u32x4*)(PR + (row - 1) * 1792 + 1024 + cg) : (u32x4){0u, 0u, 0u, 0u};
      }
    }
#define RW_UNPK(dst, v) do { dst[0] = lo2f((v).x); dst[1] = hi2f((v).x); dst[2] = lo2f((v).y); dst[3] = hi2f((v).y); dst[4] = lo2f((v).z); dst[5] = hi2f((v).z); dst[6] = lo2f((v).w); dst[7] = hi2f((v).w); } while (0)
    {
      float wev[16];
      ld8bf(WE + row * 512 + col, wev); ld8bf(WE + row * 512 + col + 8, wev + 8);
#pragma unroll
      for (int j = 0; j < 16; j += 4) *(f32x4*)&sL[et * 64 + ec + j] = (f32x4){wev[j], wev[j + 1], wev[j + 2], wev[j + 3]};
    }
    hsync();
    {
      const int ch = tid & 63, seg = tid >> 6;
      float accs = 0.f;
#pragma unroll
      for (int i = 0; i < 16; ++i) { accs += sL[(seg * 16 + i) * 64 + ch]; sL[(seg * 16 + i) * 64 + ch] = accs; }
      hsync();
      float off = 0.f;
      for (int sg = 0; sg < seg; ++sg) off += sL[(sg * 16 + 15) * 64 + ch];
      hsync();
#pragma unroll
      for (int i = 0; i < 16; ++i) sL[(seg * 16 + i) * 64 + ch] += off;
    }
    hsync();
    u32x4 bhp[2], khp[2];
#pragma unroll
    for (int g8 = 0; g8 < 2; ++g8) {
      const int cc = ec + g8 * 8, cg = col + g8 * 8;
      float kkv[8], av[8], kpv[8], rv[8], vv[8];
      RW_UNPK(kkv, rw[g8][0]);
      RW_UNPK(av, rw[g8][1]);
      RW_UNPK(kpv, rw[g8][2]);
      {
        float rc[8], rp[8], vc[8], vp[8];
        RW_UNPK(rc, rw[g8][3]);
        RW_UNPK(vc, rw[g8][4]);
        RW_UNPK(rp, rw[g8][5]);
        RW_UNPK(vp, rw[g8][6]);
#pragma unroll
        for (int j = 0; j < 8; ++j) { rv[j] = rc[j] + (rp[j] - rc[j]) * mu[cg + j]; vv[j] = vc[j] + (vp[j] - vc[j]) * mu[1024 + cg + j]; }
      }
      float ab[8], rb[8], bt[8], kt[8], bh[8], kh[8];
#pragma unroll
      for (int j = 0; j < 8; ++j) {
        const float lt = -sL[et * 64 + cc + j], lp = (et > 0) ? -sL[(et - 1) * 64 + cc + j] : 0.f, l63 = -sL[63 * 64 + cc + j];
        const float beta = kkv[j] * av[j], em = __expf(-lt), e63 = __expf(l63 - lt);
        ab[j] = -kkv[j] * __expf(lp); rb[j] = rv[j] * __expf(lt);
        bt[j] = beta * em; kt[j] = kpv[j] * em; bh[j] = beta * e63; kh[j] = kpv[j] * e63;
      }
      u32x4 o;
#define PK8(dst, a_) o.x = pk2(a_[0], a_[1]); o.y = pk2(a_[2], a_[3]); o.z = pk2(a_[4], a_[5]); o.w = pk2(a_[6], a_[7]); dst = o
      PK8(*(u32x4*)(R0 + et * 72 + cc), ab);
      PK8(*(u32x4*)(R1 + et * 72 + cc), rb);
      PK8(*(u32x4*)(R2 + et * 72 + cc), bt);
      PK8(*(u32x4*)(R3 + et * 72 + cc), kt);
      PK8(bhp[g8], bh);
      PK8(khp[g8], kh);
#undef PK8
#pragma unroll
      for (int j = 0; j < 8; ++j) R6[(cc + j) * 72 + et] = f2bf(vv[j]);
    }
    if (et == 63) {
#pragma unroll
      for (int j = 0; j < 16; ++j) LAM[(size_t)task * 64 + ec + j] = __expf(-sL[63 * 64 + ec + j]);
    }
    hsync();
    f32x4 mab[4], mak[4], mrb[4], mrk[4];
#pragma unroll
    for (int n = 0; n < 4; ++n) { mab[n] = (f32x4){0.f, 0.f, 0.f, 0.f}; mak[n] = mab[n]; mrb[n] = mab[n]; mrk[n] = mab[n]; }
#pragma unroll
    for (int kk = 0; kk < 2; ++kk) {
      const bf16x8 fa = RW_FRAG(R0, wid * 16 + fr, kk), frb = RW_FRAG(R1, wid * 16 + fr, kk);
#pragma unroll
      for (int n = 0; n < 4; ++n) {
        const bf16x8 fb = RW_FRAG(R2, n * 16 + fr, kk), fk = RW_FRAG(R3, n * 16 + fr, kk);
        RW_MMA(mab[n], fb, fa); RW_MMA(mak[n], fk, fa); RW_MMA(mrb[n], fb, frb); RW_MMA(mrk[n], fk, frb);
      }
    }
    {
      const int t = wid * 16 + fr;
#pragma unroll
      for (int n = 0; n < 4; ++n)
#pragma unroll
        for (int j = 0; j < 4; ++j) {
          const int s_ = n * 16 + fq * 4 + j;
          if (s_ >= t) { mab[n][j] = 0.f; mak[n][j] = 0.f; }
          if (s_ > t) { mrb[n][j] = 0.f; mrk[n][j] = 0.f; }
        }
    }
    u32x2 mrbp[4], mrkp[4];
#pragma unroll
    for (int n = 0; n < 4; ++n) {
      mrbp[n].x = pk2(mrb[n].x, mrb[n].y); mrbp[n].y = pk2(mrb[n].z, mrb[n].w);
      mrkp[n].x = pk2(mrk[n].x, mrk[n].y); mrkp[n].y = pk2(mrk[n].z, mrk[n].w);
    }
    u32x2 rbq[4];
#pragma unroll
    for (int n = 0; n < 4; ++n) rbq[n] = *(const u32x2*)(R1 + (wid * 16 + fr) * 72 + n * 16 + fq * 4);
    hsync();
    {
      const int t = wid * 16 + fr;
#pragma unroll
      for (int n = 0; n < 4; ++n) {
        st4bf(R4 + t * 72 + n * 16 + fq * 4, mab[n].x, mab[n].y, mab[n].z, mab[n].w);
        st4bf(R2 + t * 72 + n * 16 + fq * 4, mak[n].x, mak[n].y, mak[n].z, mak[n].w);
      }
    }
    hsync();
    {
      f32x4 r2[4];
#pragma unroll
      for (int n = 0; n < 4; ++n) r2[n] = (f32x4){0.f, 0.f, 0.f, 0.f};
#pragma unroll
      for (int kk = 0; kk < 2; ++kk) {
        const bf16x8 fm = RW_FRAG(R2, wid * 16 + fr, kk);
#pragma unroll
        for (int n = 0; n < 4; ++n) { const bf16x8 fv = RW_FRAG(R6, n * 16 + fr, kk); RW_MMA(r2[n], fv, fm); }
      }
#pragma unroll
      for (int n = 0; n < 4; ++n) st4bf(R3 + (wid * 16 + fr) * 72 + n * 16 + fq * 4, r2[n].x, r2[n].y, r2[n].z, r2[n].w);
    }
    hsync();
    {
      float* sBB = (float*)(R4 + 64 * 72);
      const bf16_t* src = (tid < 64) ? (R0 + tid) : (R3 + ((tid - 64) & 63));
      bf16_t* dst = (tid < 64) ? (R2 + tid * 72) : (R1 + ((tid - 64) & 63) * 72);
      if (tid < 128) {
#pragma unroll
        for (int t = 0; t < 64; t += 8) *(u32x4*)(dst + t) = (u32x4){0u, 0u, 0u, 0u};
      }
      hsync();
#pragma unroll 1
      for (int ib = 0; ib < 4; ++ib) {
        if (ib > 0) {
          const bf16_t* XT = (wid < 2) ? (R2 + (32 * wid) * 72) : (R1 + (32 * (wid - 2)) * 72);
          f32x4 o2[2];
          o2[0] = (f32x4){0.f, 0.f, 0.f, 0.f}; o2[1] = o2[0];
#pragma unroll
          for (int kk = 0; kk < 2; ++kk) {
            const bf16x8 fm = RW_FRAG(R4, ib * 16 + fr, kk);
#pragma unroll
            for (int n2 = 0; n2 < 2; ++n2) { const bf16x8 fx = RW_FRAG(XT, n2 * 16 + fr, kk); RW_MMA(o2[n2], fx, fm); }
          }
#pragma unroll
          for (int n2 = 0; n2 < 2; ++n2) *(f32x4*)&sBB[fr * 128 + 32 * wid + n2 * 16 + fq * 4] = o2[n2];
          hsync();
        }
        if (tid < 128) {
          typedef __bf16 bfp2 __attribute__((ext_vector_type(2)));
          unsigned xp[8];
#pragma unroll
          for (int k = 0; k < 8; ++k) xp[k] = 0u;
#pragma unroll
          for (int tt = 0; tt < 16; ++tt) {
            const int t = ib * 16 + tt;
            float acc = bf2f(src[t * 72]);
            if (ib > 0) acc += sBB[tt * 128 + tid];
            if (tt > 0) {
              const u32x4 m0 = *(const u32x4*)(R4 + t * 72 + ib * 16);
              const u32x4 m1 = (tt > 8) ? *(const u32x4*)(R4 + t * 72 + ib * 16 + 8) : (u32x4){0u, 0u, 0u, 0u};
              const unsigned mp[8] = {m0.x, m0.y, m0.z, m0.w, m1.x, m1.y, m1.z, m1.w};
#pragma unroll
              for (int k = 0; k < (tt + 1) / 2; ++k) acc = __builtin_amdgcn_fdot2_f32_bf16(__builtin_bit_cast(bfp2, mp[k]), __builtin_bit_cast(bfp2, xp[k]), acc, false);
            }
            const unsigned xb = (unsigned)f2bf(acc);
            xp[tt >> 1] = (tt & 1) ? (xp[tt >> 1] | (xb << 16)) : xb;
          }
          *(u32x4*)(dst + ib * 16) = (u32x4){xp[0], xp[1], xp[2], xp[3]};
          *(u32x4*)(dst + ib * 16 + 8) = (u32x4){xp[4], xp[5], xp[6], xp[7]};
        }
        hsync();
      }
    }
    {
      const int t = wid * 16 + fr;
#pragma unroll
      for (int n = 0; n < 4; ++n) {
        *(u32x2*)(R0 + t * 72 + n * 16 + fq * 4) = mrbp[n];
        *(u32x2*)(R3 + t * 72 + n * 16 + fq * 4) = mrkp[n];
      }
      bf16_t* R5 = R4 + 64 * 72;
      const unsigned b4[8] = {bhp[0].x, bhp[0].y, bhp[0].z, bhp[0].w, bhp[1].x, bhp[1].y, bhp[1].z, bhp[1].w};
      const unsigned k4[8] = {khp[0].x, khp[0].y, khp[0].z, khp[0].w, khp[1].x, khp[1].y, khp[1].z, khp[1].w};
#pragma unroll
      for (int j = 0; j < 8; ++j) {
        R4[(ec + 2 * j) * 72 + et] = (bf16_t)(b4[j] & 0xffffu); R4[(ec + 2 * j + 1) * 72 + et] = (bf16_t)(b4[j] >> 16);
        R5[(ec + 2 * j) * 72 + et] = (bf16_t)(k4[j] & 0xffffu); R5[(ec + 2 * j + 1) * 72 + et] = (bf16_t)(k4[j] >> 16);
      }
    }
    hsync();
    {
      const bf16_t* R5 = R4 + 64 * 72;
      const int rr = wid * 16 + fr;
#define RW_PROD(acc, MT1, NT1, HAS2, MT2, NT2) do { \
        _Pragma("unroll") for (int n = 0; n < 4; ++n) acc[n] = (f32x4){0.f, 0.f, 0.f, 0.f}; \
        _Pragma("unroll") for (int kk = 0; kk < 2; ++kk) { \
          const bf16x8 _m1 = RW_FRAG(MT1, rr, kk); \
          _Pragma("unroll") for (int n = 0; n < 4; ++n) { const bf16x8 _n1 = RW_FRAG(NT1, n * 16 + fr, kk); RW_MMA(acc[n], _n1, _m1); } \
          if (HAS2) { const bf16x8 _m2 = RW_FRAG(MT2, rr, kk); \
            _Pragma("unroll") for (int n = 0; n < 4; ++n) { const bf16x8 _n2 = RW_FRAG(NT2, n * 16 + fr, kk); RW_MMA(acc[n], _n2, _m2); } } \
        } } while (0)
      f32x4 o4[4];
      RW_PROD(o4, R0, R2, false, R0, R2);
#pragma unroll
      for (int n = 0; n < 4; ++n)
        st4bf(KK + (row0 + rr) * 512 + h * 64 + n * 16 + fq * 4, o4[n].x + lo2f(rbq[n].x), o4[n].y + hi2f(rbq[n].x), o4[n].z + lo2f(rbq[n].y), o4[n].w + hi2f(rbq[n].y));
      __builtin_amdgcn_sched_barrier(0);
      RW_PROD(o4, R0, R1, true, R3, R6);
#pragma unroll
      for (int n = 0; n < 4; ++n) st4bf(RA + (row0 + rr) * 512 + h * 64 + n * 16 + fq * 4, o4[n].x, o4[n].y, o4[n].z, o4[n].w);
      __builtin_amdgcn_sched_barrier(0);
      RW_PROD(o4, R4, R2, false, R4, R2);
#pragma unroll
      for (int n = 0; n < 4; ++n) st4bf(WE + (row0 + rr) * 512 + h * 64 + n * 16 + fq * 4, o4[n].x, o4[n].y, o4[n].z, o4[n].w);
      __builtin_amdgcn_sched_barrier(0);
      RW_PROD(o4, R1, R4, true, R6, R5);
#pragma unroll
      for (int n = 0; n < 4; ++n) st4bf(MIX + (row0 + rr) * 1024 + h * 64 + n * 16 + fq * 4, o4[n].x, o4[n].y, o4[n].z, o4[n].w);
#undef RW_PROD
    }
  }
}
DEVINL void phase_rwkv_chunk_b(const Params& p, int bid, int nb, char* smem) {
  const int tid = my_tid(), lane = tid & 63, wid = tid >> 6, fr = lane & 15, fq = lane >> 4;
  bf16_t* sS0 = (bf16_t*)smem;
  const bf16_t* Q1 = (const bf16_t*)(p.ws + OFF_RKK);
  bf16_t* Q2 = (bf16_t*)(p.ws + OFF_RA);
  const bf16_t* G1T = (const bf16_t*)(p.ws + OFF_RWE);
  const bf16_t* MIX = (const bf16_t*)(p.ws + OFF_MIX);
  const float* LAM = (const float*)(p.ws + OFF_LAM);
  struct Ops { bf16x8 q1f[2]; bf16x8 g1f[2]; u32x2 q2v, g2v; f32x4 lam; };
  for (int item = bid; item < 256; item += nb) {
    const int vq = item & 3, h = (item >> 2) & 7, b = item >> 5;
    auto load_ops = [&](Ops& o, int c) {
      const size_t row0 = (size_t)b * SEQ + c * 64;
      const int task = (b * 8 + h) * 64 + c;
#pragma unroll
      for (int kk = 0; kk < 2; ++kk) {
        o.q1f[kk] = *(const bf16x8*)(Q1 + (row0 + wid * 16 + fr) * 512 + h * 64 + kk * 32 + fq * 8);
        o.g1f[kk] = *(const bf16x8*)(G1T + (row0 + wid * 16 + fr) * 512 + h * 64 + kk * 32 + fq * 8);
      }
      o.q2v = *(const u32x2*)(Q2 + (row0 + wid * 16 + fr) * 512 + h * 64 + vq * 16 + fq * 4);
      o.g2v = *(const u32x2*)(MIX + (row0 + vq * 16 + fr) * 1024 + h * 64 + wid * 16 + fq * 4);
      o.lam = *(const f32x4*)(LAM + (size_t)task * 64 + wid * 16 + fq * 4);
    };
    f32x4 S = (f32x4){0.f, 0.f, 0.f, 0.f};
    auto step = [&](const Ops& o, int c) {
      const size_t row0 = (size_t)b * SEQ + c * 64;
      bf16_t* sS = sS0 + (c & 1) * (16 * 72);
      st4bf(sS + fr * 72 + wid * 16 + fq * 4, S.x, S.y, S.z, S.w);
      hsync();
      f32x4 y = (f32x4){0.f, 0.f, 0.f, 0.f}, sn = y;
#pragma unroll
      for (int kk = 0; kk < 2; ++kk) {
        const bf16x8 fs = RW_FRAG(sS, fr, kk);
        RW_MMA(sn, o.g1f[kk], fs);
        RW_MMA(y, fs, o.q1f[kk]);
      }
      S.x = S.x * o.lam.x + sn.x + lo2f(o.g2v.x); S.y = S.y * o.lam.y + sn.y + hi2f(o.g2v.x);
      S.z = S.z * o.lam.z + sn.z + lo2f(o.g2v.y); S.w = S.w * o.lam.w + sn.w + hi2f(o.g2v.y);
      st4bf(Q2 + (row0 + wid * 16 + fr) * 512 + h * 64 + vq * 16 + fq * 4, y.x + lo2f(o.q2v.x), y.y + hi2f(o.q2v.x), y.z + lo2f(o.q2v.y), y.w + hi2f(o.q2v.y));
    };
    hsync();
    Ops o0, o1, o2, o3;
    load_ops(o0, 0); load_ops(o1, 1); load_ops(o2, 2);
#pragma unroll 1
    for (int c = 0; c < 64; c += 4) {
      load_ops(o3, c + 3);
      step(o0, c);
      if (c + 4 < 64) load_ops(o0, c + 4);
      step(o1, c + 1);
      if (c + 5 < 64) load_ops(o1, c + 5);
      step(o2, c + 2);
      if (c + 6 < 64) load_ops(o2, c + 6);
      step(o3, c + 3);
    }
  }
}

namespace g8 {
#define G8_LAS __attribute__((address_space(3)))
constexpr int BM = 256, BK = 64, HALFR = 128, HTB = HALFR * BK * 2, STAGE_BYTES = 8 * HTB, NXCD = 8, WGM = 8;
DEVINL int lds_byte(int r, int c) { const int st = (r >> 4) * 2 + (c >> 5), rr = r & 15, cc = c & 31, ob = rr * 64 + cc * 2; return st * 1024 + (ob ^ (((ob >> 9) & 1) << 5)); }
DEVINL void stage_rc(int b, int& R, int& C) { const int st = b / 1024, sb = b % 1024, swz = sb ^ (((sb >> 9) & 1) << 5); R = (st >> 1) * 16 + swz / 64; C = (st & 1) * 32 + (swz % 64) / 2; }
struct Order {
  int nM, nN, nwg, G, c;
  DEVINL void init(int nM_, int nN_, int G_, int c_) { nM = nM_; nN = nN_; nwg = nM * nN; G = G_; c = c_; }
  DEVINL bool next(int i, int& pm, int& pn) const {
    const long L = (long)i * G + c; if (L >= nwg) return false;
    int wgid = (int)L; { const int q = nwg / NXCD, r = nwg % NXCD, xcd = wgid % NXCD, off = wgid / NXCD; wgid = (xcd < r ? xcd * (q + 1) : r * (q + 1) + (xcd - r) * q) + off; }
    const int nig = WGM * nN, gid = wgid / nig, fm = gid * WGM, gsz = (nM - fm) < WGM ? (nM - fm) : WGM;
    pm = fm + ((wgid % nig) % gsz); pn = (wgid % nig) / gsz; return true;
  }
  DEVINL void chunk(int x, int& start, int& len) const { const int q = nwg / NXCD, r = nwg % NXCD; start = (x < r) ? x * (q + 1) : r * (q + 1) + (x - r) * q; len = q + ((x < r) ? 1 : 0); }
  DEVINL int owner(int pm, int pn) const {
    const int nig = WGM * nN, gid = pm / WGM, fm = gid * WGM, gsz = (nM - fm) < WGM ? (nM - fm) : WGM;
    const int wgid = gid * nig + pn * gsz + (pm - fm);
    const int q = nwg / NXCD, r = nwg % NXCD;
    int x, off;
    if (wgid < r * (q + 1)) { x = wgid / (q + 1); off = wgid - x * (q + 1); } else { const int w2 = wgid - r * (q + 1); x = r + w2 / q; off = w2 - (x - r) * q; }
    return (off * NXCD + x) % G;
  }
  DEVINL void decode(int wgid, int& pm, int& pn) const {
    const int nig = WGM * nN, gid = wgid / nig, fm = gid * WGM, gsz = (nM - fm) < WGM ? (nM - fm) : WGM;
    pm = fm + ((wgid % nig) % gsz); pn = (wgid % nig) / gsz;
  }
};
template <class Job>
DEVINL void gemm8(const Job& J) {
  G8_LAS unsigned char* lds = (G8_LAS unsigned char*)g_smem;
  const int tid = threadIdx.x, wid = __builtin_amdgcn_readfirstlane(tid >> 6), lane = tid & 63, wr = wid >> 2, wc = wid & 3, fr = lane & 15, fq = lane >> 4;
  const int K = Job::K, nt = K / BK;
  int Rp[2], Cp[2];
  unsigned voffB[2];
#pragma unroll
  for (int i = 0; i < 2; ++i) { stage_rc(tid * 16 + i * 8192, Rp[i], Cp[i]); voffB[i] = (unsigned)(Rp[i] * K + Cp[i]) * 2u; }
  const size_t kstep = (size_t)(BK * 2);
  const size_t hstepB = (size_t)HALFR * K * 2;
  const unsigned ldsw = (unsigned)wid * 1024u;
  const int aoff = lds_byte(wr * 64 + fr, fq * 8), boff = lds_byte(wc * 32 + fr, fq * 8);
#define G8_SA(b, h) (((b) * 2 + (h)) * HTB)
#define G8_SB(b, h) ((4 + (b) * 2 + (h)) * HTB)
#define G8_STAGE(bufoff, gbase, voff) do { _Pragma("unroll") for (int _i = 0; _i < 2; ++_i) \
    __builtin_amdgcn_global_load_lds((const unsigned*)((const char*)(gbase) + (voff)[_i]), (G8_LAS unsigned*)(lds + (bufoff) + ldsw + _i * 8192), 16, 0, 0); } while (0)
#define G8_LDA(dst, b, h) do { _Pragma("unroll") for (int m = 0; m < 4; ++m) _Pragma("unroll") for (int k = 0; k < 2; ++k) dst[m][k] = *(const G8_LAS bf16x8*)(lds + G8_SA(b, h) + aoff + m * 2048 + k * 1024); } while (0)
#define G8_LDB(dst, b, h) do { _Pragma("unroll") for (int n = 0; n < 2; ++n) _Pragma("unroll") for (int k = 0; k < 2; ++k) dst[n][k] = *(const G8_LAS bf16x8*)(lds + G8_SB(b, h) + boff + n * 2048 + k * 1024); } while (0)
#define G8_MMA(ai, bj, At, Bt) do { __builtin_amdgcn_s_setprio(1); _Pragma("unroll") for (int m = 0; m < 4; ++m) _Pragma("unroll") for (int n = 0; n < 2; ++n) _Pragma("unroll") for (int k = 0; k < 2; ++k) \
    acc[ai][bj][m][n] = __builtin_amdgcn_mfma_f32_16x16x32_bf16(Bt[n][k], At[m][k], acc[ai][bj][m][n], 0, 0, 0); __builtin_amdgcn_s_setprio(0); } while (0)
#define G8_WAIT_V(n) asm volatile("s_waitcnt vmcnt(" #n ")" ::: "memory")
#define G8_WAIT_L(n) asm volatile("s_waitcnt lgkmcnt(" #n ")" ::: "memory")
#define G8_BAR __builtin_amdgcn_s_barrier()
#define G8_SCHED __builtin_amdgcn_sched_barrier(0)
  Order S; S.init(J.nM(), J.nN(), gridDim.x, blockIdx.x);
  int cpm, cpn, npm = 0, npn = 0, ui = 0;
  int nxtL = 0, nun = 0, qstart = 0;
  volatile int* qslot = (volatile int*)(g_smem + STAGE_BYTES + 768);
  if constexpr (Job::DYN) {
    S.chunk((int)(blockIdx.x & 7), qstart, nun);
    if (tid == 0) { const int b0 = (int)atomicAdd(J.queue() + (blockIdx.x & 7) * 16, 2u); qslot[0] = b0; qslot[1] = b0 + 1; }
    __syncthreads();
    const int curL = __builtin_amdgcn_readfirstlane(qslot[0]); nxtL = __builtin_amdgcn_readfirstlane(qslot[1]);
    __syncthreads();
    if (curL >= nun) return;
    S.decode(qstart + curL, cpm, cpn);
    J.wait_ready(S, cpm, lane);
  } else {
    if (!S.next(0, cpm, cpn)) return;
  }
  f32x4 acc[2][2][4][2];
#pragma unroll
  for (int a = 0; a < 2; ++a)
#pragma unroll
    for (int b = 0; b < 2; ++b)
#pragma unroll
      for (int m = 0; m < 4; ++m)
#pragma unroll
        for (int n = 0; n < 2; ++n) acc[a][b][m][n] = (f32x4){0.f, 0.f, 0.f, 0.f};
  bf16x8 At[4][2], B0[2][2], B1[2][2];
  const char* cA = J.a_base(cpm); const char* cB = J.b_base(cpm, cpn);
  unsigned cv0[2], cv1[2];
  { unsigned v[2][2]; J.a_voff(cpm, Rp, Cp, v); cv0[0] = v[0][0]; cv0[1] = v[0][1]; cv1[0] = v[1][0]; cv1[1] = v[1][1]; }
  G8_STAGE(G8_SB(0, 0), cB, voffB); G8_STAGE(G8_SA(0, 0), cA, cv0); G8_STAGE(G8_SB(0, 1), cB + hstepB, voffB); G8_STAGE(G8_SA(0, 1), cA, cv1);
  if (wr == 1) G8_BAR;
  G8_WAIT_V(4); G8_BAR;
  G8_STAGE(G8_SB(1, 0), cB + kstep, voffB); G8_STAGE(G8_SA(1, 0), cA + kstep, cv0); G8_STAGE(G8_SB(1, 1), cB + hstepB + kstep, voffB);
  G8_WAIT_V(6); G8_BAR;
  for (;;) {
    bool has_next;
    int nnL = 0;
    unsigned rdyv = 4u;
    if constexpr (Job::DYN) {
      has_next = nxtL < nun;
      if (has_next) { S.decode(qstart + nxtL, npm, npn); rdyv = J.peek(npm); }
      if (tid == 0) nnL = (int)atomicAdd(J.queue() + (blockIdx.x & 7) * 16, 1u);
    } else has_next = S.next(ui + 1, npm, npn);
    const char* nA = has_next ? J.a_base(npm) : cA; const char* nB = has_next ? J.b_base(npm, npn) : cB;
    unsigned nv0[2] = {cv0[0], cv0[1]}, nv1[2] = {cv1[0], cv1[1]};
    if (has_next) { unsigned v[2][2]; J.a_voff(npm, Rp, Cp, v); nv0[0] = v[0][0]; nv0[1] = v[0][1]; nv1[0] = v[1][0]; nv1[1] = v[1][1]; }
    for (int t = 0; t < nt; t += 2) {
      const bool last = (t == nt - 2);
      if constexpr (Job::DYN) { if (last && has_next) { while (rdyv < 4u) { __builtin_amdgcn_s_sleep(1); rdyv = J.peek(npm); } } }
      const char* a1 = cA + (size_t)(t + 1) * kstep;
      const char* a2 = last ? nA : cA + (size_t)(t + 2) * kstep; const char* b2 = last ? nB : cB + (size_t)(t + 2) * kstep;
      const char* a3 = a2 + kstep; const char* b3 = b2 + kstep;
      const unsigned x0[2] = {last ? nv0[0] : cv0[0], last ? nv0[1] : cv0[1]}, x1[2] = {last ? nv1[0] : cv1[0], last ? nv1[1] : cv1[1]};
      G8_LDB(B0, 0, 0); G8_SCHED; G8_LDA(At, 0, 0); G8_STAGE(G8_SA(1, 1), a1, cv1);
      G8_WAIT_L(8); G8_BAR; G8_WAIT_L(0); G8_MMA(0, 0, At, B0); G8_BAR; G8_SCHED;
      G8_LDB(B1, 0, 1); G8_STAGE(G8_SB(0, 0), b2, voffB);
      G8_BAR; G8_WAIT_L(0); G8_MMA(0, 1, At, B1); G8_BAR;
      G8_LDA(At, 0, 1); G8_STAGE(G8_SA(0, 0), a2, x0);
      G8_BAR; G8_WAIT_L(0); G8_MMA(1, 0, At, B0); G8_BAR; G8_SCHED;
      G8_STAGE(G8_SB(0, 1), b2 + hstepB, voffB);
      G8_WAIT_V(6); G8_BAR; G8_MMA(1, 1, At, B1); G8_BAR;
      G8_LDB(B0, 1, 0); G8_SCHED; G8_LDA(At, 1, 0); G8_STAGE(G8_SA(0, 1), a2, x1);
      G8_WAIT_L(8); G8_BAR; G8_WAIT_L(0); G8_MMA(0, 0, At, B0); G8_BAR; G8_SCHED;
      G8_LDB(B1, 1, 1); G8_STAGE(G8_SB(1, 0), b3, voffB);
      G8_BAR; G8_WAIT_L(0); G8_MMA(0, 1, At, B1); G8_BAR;
      G8_LDA(At, 1, 1); G8_STAGE(G8_SA(1, 0), a3, x0);
      G8_BAR; G8_WAIT_L(0); G8_MMA(1, 0, At, B0); G8_BAR; G8_SCHED;
      G8_STAGE(G8_SB(1, 1), b3 + hstepB, voffB);
      G8_WAIT_V(6); G8_BAR; G8_MMA(1, 1, At, B1); G8_BAR;
    }
    J.epi(acc, cpm, cpn, wr, wc, fr, fq);
    if constexpr (Job::PUBLISH) {
      G8_WAIT_V(0);
      G8_BAR;
      if (tid == 256) J.publish(cpm);
    }
    if constexpr (Job::DYN) {
      if (tid == 0) qslot[0] = nnL;
      G8_WAIT_L(0);
      G8_BAR;
    }
    if (!has_next) break;
#pragma unroll
    for (int a = 0; a < 2; ++a)
#pragma unroll
      for (int b = 0; b < 2; ++b)
#pragma unroll
        for (int m = 0; m < 4; ++m)
#pragma unroll
          for (int n = 0; n < 2; ++n) acc[a][b][m][n] = (f32x4){0.f, 0.f, 0.f, 0.f};
    cpm = npm; cpn = npn; cA = nA; cB = nB; cv0[0] = nv0[0]; cv0[1] = nv0[1]; cv1[0] = nv1[0]; cv1[1] = nv1[1]; ++ui;
    if constexpr (Job::DYN) nxtL = __builtin_amdgcn_readfirstlane(qslot[0]);
  }
  G8_WAIT_V(0);
  if (wr == 0) G8_BAR;
  G8_BAR;
#undef G8_SA
#undef G8_SB
#undef G8_STAGE
#undef G8_LDA
#undef G8_LDB
#undef G8_MMA
#undef G8_WAIT_V
#undef G8_WAIT_L
#undef G8_BAR
#undef G8_SCHED
}
typedef f32x4 Acc8[2][2][4][2];
#define G8_EPI_LOOP _Pragma("unroll") for (int ai = 0; ai < 2; ++ai) _Pragma("unroll") for (int m = 0; m < 4; ++m) _Pragma("unroll") for (int bj = 0; bj < 2; ++bj) _Pragma("unroll") for (int n = 0; n < 2; ++n)
#define G8_ROW (256 * pm + 128 * ai + 64 * wr + 16 * m + fr)
#define G8_COL (256 * pn + 128 * bj + 32 * wc + 16 * n + 4 * fq)
template <int LDA> DEVINL void a_voff_regular(const int (&R)[2], const int (&C)[2], unsigned (&v)[2][2]) {
#pragma unroll
  for (int h = 0; h < 2; ++h)
#pragma unroll
    for (int i = 0; i < 2; ++i) v[h][i] = (unsigned)((h * 128 + R[i]) * LDA + C[i]) * 2u;
}
struct JobIn0 {
  static constexpr bool DYN = false, PUBLISH = false;
  static constexpr int K = 1024;
  const bf16_t* A; const bf16_t* B; bf16_t* C; bf16_t* U;
  DEVINL int nM() const { return T / 256; } DEVINL int nN() const { return 8; }
  DEVINL const char* a_base(int pm) const { return (const char*)(A + (size_t)pm * 256 * 1024); }
  DEVINL void a_voff(int, const int (&R)[2], const int (&Cc)[2], unsigned (&v)[2][2]) const { a_voff_regular<1024>(R, Cc, v); }
  DEVINL const char* b_base(int, int pn) const { return (const char*)(B + (size_t)pn * 256 * 1024); }
  DEVINL void epi(const Acc8& acc, int pm, int pn, int wr, int wc, int fr, int fq) const {
    if (pn < 2) {
      G8_EPI_LOOP { const int col = G8_COL; st4bf(U + ((size_t)(col >> 4) * T + G8_ROW) * 16 + (col & 15), acc[ai][bj][m][n].x, acc[ai][bj][m][n].y, acc[ai][bj][m][n].z, acc[ai][bj][m][n].w); }
    } else {
      G8_EPI_LOOP st4bf(C + (size_t)G8_ROW * 2048 + G8_COL, acc[ai][bj][m][n].x, acc[ai][bj][m][n].y, acc[ai][bj][m][n].z, acc[ai][bj][m][n].w);
    }
  }
};
struct JobIn1 {
  static constexpr bool DYN = false, PUBLISH = false;
  static constexpr int K = 1024;
  const bf16_t* A; const bf16_t* B; bf16_t* CR; bf16_t* CM; float* DT;
  DEVINL int nM() const { return T / 256; } DEVINL int nN() const { return 14; }
  DEVINL const char* a_base(int pm) const { return (const char*)(A + (size_t)pm * 256 * 1024); }
  DEVINL void a_voff(int, const int (&R)[2], const int (&Cc)[2], unsigned (&v)[2][2]) const { a_voff_regular<1024>(R, Cc, v); }
  DEVINL const char* b_base(int, int pn) const { return (const char*)(B + (size_t)pn * 256 * 1024); }
  DEVINL void epi(const Acc8& acc, int pm, int pn, int wr, int wc, int fr, int fq) const {
    G8_EPI_LOOP {
      const int row = G8_ROW, col = G8_COL; const f32x4 a = acc[ai][bj][m][n];
      if (col < 1792) st4bf(CR + (size_t)row * 1792 + col, a.x, a.y, a.z, a.w);
      else if (col < 3456) {
        st4bf(CM + (size_t)row * 1664 + (col - 1792), a.x, a.y, a.z, a.w);
        if (col >= 3328 && col < 3336) *(f32x4*)(DT + (size_t)row * 8 + (col - 3328)) = a;
      }
    }
  }
};
struct JobGlu {
  static constexpr bool DYN = false, PUBLISH = false;
  static constexpr int K = 512;
  const bf16_t* A; const bf16_t* B; bf16_t* C;
  DEVINL int nM() const { return T / 256; } DEVINL int nN() const { return 4; }
  DEVINL const char* a_base(int pm) const { return (const char*)(A + (size_t)pm * 256 * 512); }
  DEVINL void a_voff(int, const int (&R)[2], const int (&Cc)[2], unsigned (&v)[2][2]) const { a_voff_regular<512>(R, Cc, v); }
  DEVINL const char* b_base(int, int pn) const { return (const char*)(B + (size_t)pn * 256 * 512); }
  DEVINL void epi(const Acc8& acc, int pm, int pn, int wr, int wc, int fr, int fq) const {
#pragma unroll
    for (int ai = 0; ai < 2; ++ai)
#pragma unroll
      for (int m = 0; m < 4; ++m)
#pragma unroll
        for (int bj = 0; bj < 2; ++bj) {
          const int row = 256 * pm + 128 * ai + 64 * wr + 16 * m + fr, hc = (256 * pn + 128 * bj + 32 * wc) / 2 + 4 * fq;
          const f32x4 a = acc[ai][bj][m][0], g = acc[ai][bj][m][1];
          st4bf(C + (size_t)row * 1024 + hc, a.x * sigmoid_(g.x), a.y * sigmoid_(g.y), a.z * sigmoid_(g.z), a.w * sigmoid_(g.w));
        }
  }
};
template <int LYR>
struct JobOut {
  static constexpr bool DYN = false, PUBLISH = false;
  static constexpr int K = 1024;
  const bf16_t* A; const bf16_t* B; const float* xin32; const bf16_t* xin16; bf16_t* xo; const float* gate1;
  DEVINL int nM() const { return T / 256; } DEVINL int nN() const { return 4; }
  DEVINL const char* a_base(int pm) const { return (const char*)(A + (size_t)pm * 256 * 1024); }
  DEVINL void a_voff(int, const int (&R)[2], const int (&Cc)[2], unsigned (&v)[2][2]) const { a_voff_regular<1024>(R, Cc, v); }
  DEVINL const char* b_base(int, int pn) const { return (const char*)(B + (size_t)pn * 256 * 1024); }
  DEVINL void epi(const Acc8& acc, int pm, int pn, int wr, int wc, int fr, int fq) const {
    const float* gt = gate1 + (size_t)((pm * 256) >> 12) * 6144;
#pragma unroll
    for (int ai = 0; ai < 2; ++ai)
#pragma unroll
      for (int m = 0; m < 4; ++m) {
        const int row = 256 * pm + 128 * ai + 64 * wr + 16 * m + fr;
        f32x4 x[2][2], g[2][2];
#pragma unroll
        for (int bj = 0; bj < 2; ++bj)
#pragma unroll
          for (int n = 0; n < 2; ++n) g[bj][n] = *(const f32x4*)(gt + 256 * pn + 128 * bj + 32 * wc + 16 * n + 4 * fq);
#pragma unroll
        for (int bj = 0; bj < 2; ++bj)
#pragma unroll
          for (int n = 0; n < 2; ++n) {
            const int col = 256 * pn + 128 * bj + 32 * wc + 16 * n + 4 * fq;
            if (LYR == 0) x[bj][n] = *(const f32x4*)(xin32 + (size_t)row * 1024 + col);
            else { float t4[4]; ld4bf(xin16 + (size_t)row * 1024 + col, t4); x[bj][n] = (f32x4){t4[0], t4[1], t4[2], t4[3]}; }
          }
#pragma unroll
        for (int bj = 0; bj < 2; ++bj)
#pragma unroll
          for (int n = 0; n < 2; ++n) {
            const int col = 256 * pn + 128 * bj + 32 * wc + 16 * n + 4 * fq;
            const f32x4 a = acc[ai][bj][m][n];
            st4bf(xo + (size_t)row * 1024 + col, x[bj][n].x + g[bj][n].x * a.x, x[bj][n].y + g[bj][n].y * a.y, x[bj][n].z + g[bj][n].z * a.z, x[bj][n].w + g[bj][n].w * a.w);
          }
      }
  }
};
DEVINL int moe_expert_of(const int* pst, int ti) { int e = 0; while (pst[e + 1] <= ti * 256) ++e; return e; }
struct JobMoeGu {
  static constexpr bool DYN = false, PUBLISH = true; unsigned* ready;
  DEVINL void publish(int pm) const { (void)__hip_atomic_fetch_add(ready + pm, 1u, __ATOMIC_RELAXED, __HIP_MEMORY_SCOPE_AGENT); }
  static constexpr int K = 1024;
  const bf16_t* Hh; const bf16_t* W; const int* list; const int* cnt; const int* pst; bf16_t* ACT;
  DEVINL int nM() const { return pst[32] >> 8; } DEVINL int nN() const { return 4; }
  DEVINL const char* a_base(int) const { return (const char*)Hh; }
  DEVINL void a_voff(int pm, const int (&R)[2], const int (&Cc)[2], unsigned (&v)[2][2]) const {
    const int e = moe_expert_of(pst, pm), c_e = cnt[e * 32], pos0 = pm * 256 - pst[e];
#pragma unroll
    for (int h = 0; h < 2; ++h)
#pragma unroll
      for (int i = 0; i < 2; ++i) { const int pos = pos0 + h * 128 + R[i]; const int tk = (pos < c_e) ? list[(size_t)e * T + pos] : 0; v[h][i] = (unsigned)(tk * 1024 + Cc[i]) * 2u; }
  }
  DEVINL const char* b_base(int pm, int pn) const { return (const char*)(W + ((size_t)moe_expert_of(pst, pm) * 1024 + pn * 256) * 1024); }
  DEVINL void epi(const Acc8& acc, int pm, int pn, int wr, int wc, int fr, int fq) const {
#pragma unroll
    for (int ai = 0; ai < 2; ++ai)
#pragma unroll
      for (int m = 0; m < 4; ++m)
#pragma unroll
        for (int bj = 0; bj < 2; ++bj) {
          const int row = 256 * pm + 128 * ai + 64 * wr + 16 * m + fr, hc = (256 * pn + 128 * bj + 32 * wc) / 2 + 4 * fq;
          const f32x4 g = acc[ai][bj][m][0], u = acc[ai][bj][m][1];
          st4bf_wt(ACT + (size_t)row * 512 + hc, silu_(g.x) * u.x, silu_(g.y) * u.y, silu_(g.z) * u.z, silu_(g.w) * u.w);
        }
  }
};
struct JobMoeDown {
  static constexpr bool DYN = false, PUBLISH = false;
  static constexpr int K = 512;
  const bf16_t* A; const bf16_t* W; const int* pst; bf16_t* Y;
  DEVINL int nM() const { return pst[32] >> 8; } DEVINL int nN() const { return 4; }
  DEVINL const char* a_base(int pm) const { return (const char*)(A + (size_t)pm * 256 * 512); }
  DEVINL void a_voff(int, const int (&R)[2], const int (&Cc)[2], unsigned (&v)[2][2]) const { a_voff_regular<512>(R, Cc, v); }
  DEVINL const char* b_base(int pm, int pn) const { return (const char*)(W + ((size_t)moe_expert_of(pst, pm) * 1024 + pn * 256) * 512); }
  DEVINL void epi(const Acc8& acc, int pm, int pn, int wr, int wc, int fr, int fq) const {
    G8_EPI_LOOP st4bf(Y + (size_t)G8_ROW * 1024 + G8_COL, acc[ai][bj][m][n].x, acc[ai][bj][m][n].y, acc[ai][bj][m][n].z, acc[ai][bj][m][n].w);
  }
};
struct JobMoeDownQ {
  static constexpr bool DYN = true, PUBLISH = false; unsigned* ready; unsigned* qhead;
  DEVINL unsigned* queue() const { return qhead; }
  DEVINL unsigned peek(int pm) const { return __hip_atomic_load(ready + pm, __ATOMIC_RELAXED, __HIP_MEMORY_SCOPE_AGENT); }
  DEVINL void wait_ready(const Order&, int pm, int lane) const {
    if (lane == 0) while (__hip_atomic_load(ready + pm, __ATOMIC_RELAXED, __HIP_MEMORY_SCOPE_AGENT) < 4u) __builtin_amdgcn_s_sleep(1);
    asm volatile("" ::: "memory");
  }
  static constexpr int K = 512;
  const bf16_t* A; const bf16_t* W; const int* pst; bf16_t* Y;
  DEVINL int nM() const { return pst[32] >> 8; } DEVINL int nN() const { return 4; }
  DEVINL const char* a_base(int pm) const { return (const char*)(A + (size_t)pm * 256 * 512); }
  DEVINL void a_voff(int, const int (&R)[2], const int (&Cc)[2], unsigned (&v)[2][2]) const { a_voff_regular<512>(R, Cc, v); }
  DEVINL const char* b_base(int pm, int pn) const { return (const char*)(W + ((size_t)moe_expert_of(pst, pm) * 1024 + pn * 256) * 512); }
  DEVINL void epi(const Acc8& acc, int pm, int pn, int wr, int wc, int fr, int fq) const {
    G8_EPI_LOOP st4bf(Y + (size_t)G8_ROW * 1024 + G8_COL, acc[ai][bj][m][n].x, acc[ai][bj][m][n].y, acc[ai][bj][m][n].z, acc[ai][bj][m][n].w);
  }
};
}
DEVINL void phase8_inproj0(const Params& p) { g8::JobIn0 J{(const bf16_t*)(p.ws + OFF_H), (const bf16_t*)(p.ws + OFF_WIN0), (bf16_t*)(p.ws + OFF_PROJ0), (bf16_t*)(p.ws + OFF_S5U)}; g8::gemm8(J); }
DEVINL void phase8_inproj1(const Params& p) { g8::JobIn1 J{(const bf16_t*)(p.ws + OFF_H), (const bf16_t*)(p.ws + OFF_WIN1), (bf16_t*)(p.ws + OFF_PROJR), (bf16_t*)(p.ws + OFF_PROJM), (float*)(p.ws + OFF_DTRAW)}; g8::gemm8(J); }
DEVINL void phase8_glu(const Params& p) { g8::JobGlu J{(const bf16_t*)(p.ws + OFF_YS), (const bf16_t*)(p.ws + OFF_WGLU), (bf16_t*)(p.ws + OFF_MIX)}; g8::gemm8(J); }
DEVINL void phase8_outproj(const Params& p, int L) {
  const float* g1 = (const float*)(p.ws + OFF_MOD) + (size_t)L * 8 * 6144 + 2 * 1024;
  if (L == 0) { g8::JobOut<0> J{(const bf16_t*)(p.ws + OFF_MIX), (const bf16_t*)(p.ws + OFF_WOUT0), p.in[I_X], nullptr, (bf16_t*)p.out, g1}; g8::gemm8(J); }
  else { g8::JobOut<1> J{(const bf16_t*)(p.ws + OFF_MIX), (const bf16_t*)(p.ws + OFF_WOUT1), nullptr, (const bf16_t*)p.out, (bf16_t*)(p.ws + OFF_XR1), g1}; g8::gemm8(J); }
}
DEVINL int* moe_prefix8(const Params& p, int L) {
  int* pst = (int*)(g_smem + g8::STAGE_BYTES + 64);
  const int* ctl = (const int*)(p.ws + OFF_CTL);
  if (threadIdx.x == 0) {
    int sum = 0;
    for (int e = 0; e < 32; ++e) { pst[e] = sum; sum += ((ctl[CTL_COUNT + (L * 32 + e) * 32] + 255) >> 8) << 8; }
    pst[32] = sum;
  }
  __syncthreads();
  return pst;
}
DEVINL void phase8_moe_gd(const Params& p, int L) {
  const int* pst = moe_prefix8(p, L);
  unsigned* ctl = (unsigned*)(p.ws + OFF_CTL);
  {
    g8::JobMoeGu J{ctl + CTL_MOERDY + L * 512, (const bf16_t*)(p.ws + OFF_H), (const bf16_t*)(p.ws + OFF_WGU), (const int*)(p.ws + OFF_LIST), (const int*)(p.ws + OFF_CTL) + CTL_COUNT + L * 1024, pst, (bf16_t*)(p.ws + OFF_ACT)};
    g8::gemm8(J);
  }
  {
    g8::JobMoeDownQ J{ctl + CTL_MOERDY + L * 512, ctl + CTL_MOEDQ + L * 256, (const bf16_t*)(p.ws + OFF_ACT), (const bf16_t*)(p.ws + OFF_WD), pst, (bf16_t*)(p.ws + OFF_YEXP)};
    g8::gemm8(J);
  }
}
DEVINL void phase8_moe_gu(const Params& p, int L) {
  const int* pst = moe_prefix8(p, L);
  g8::JobMoeGu J{(unsigned*)(p.ws + OFF_CTL) + CTL_MOERDY + L * 512, (const bf16_t*)(p.ws + OFF_H), (const bf16_t*)(p.ws + OFF_WGU), (const int*)(p.ws + OFF_LIST), (const int*)(p.ws + OFF_CTL) + CTL_COUNT + L * 1024, pst, (bf16_t*)(p.ws + OFF_ACT)};
  g8::gemm8(J);
}
DEVINL void phase8_moe_down(const Params& p, int L) {
  const int* pst = moe_prefix8(p, L);
  g8::JobMoeDown J{(const bf16_t*)(p.ws + OFF_ACT), (const bf16_t*)(p.ws + OFF_WD), pst, (bf16_t*)(p.ws + OFF_YEXP)};
  g8::gemm8(J);
}

#define XB_TMO      128
#define XB_XCNT(j)  (256  + 64 * (j))
#define XB_XSUB(j)  (1280 + 64 * (j))
#define XB_XGEN(j)  (2304 + 64 * (j))
#define XB_TOP      3328
#define XB_TOPGEN   3392
#define XB_SPIN_CAP (1u << 22)
#define LAS __attribute__((address_space(3)))
DEVINL unsigned xb_ld(unsigned* p) { return __hip_atomic_load(p, __ATOMIC_RELAXED, __HIP_MEMORY_SCOPE_AGENT); }
DEVINL unsigned xb_add(unsigned* p, unsigned v) { return __hip_atomic_fetch_add(p, v, __ATOMIC_RELAXED, __HIP_MEMORY_SCOPE_AGENT); }
DEVINL unsigned xb_xcc_id() { return (unsigned)__builtin_amdgcn_s_getreg((3 << 11) | 20) & 0xFu; }
#define XB_SPIN(cond, bar) do { unsigned _sp = 0; while (cond) { __builtin_amdgcn_s_sleep(1); \
    if ((++_sp & 255u) == 0u) { if (xb_ld(&(bar)[XB_TMO])) break; if (_sp > XB_SPIN_CAP) { atomicAdd(&(bar)[XB_TMO], 1u); break; } } } } while (0)
struct XcdBarrier { unsigned* bar; unsigned x; volatile unsigned* st; };
DEVINL XcdBarrier xcd_barrier_post(unsigned* bar, volatile unsigned* st) {
  XcdBarrier b; b.bar = bar; b.x = xb_xcc_id(); b.st = st;
  if ((int)threadIdx.x == 0) (void)xb_add(&bar[XB_XCNT(b.x)], 1u);
  return b;
}
DEVINL void xcd_barrier_complete(unsigned* bar, unsigned x, unsigned& nloc, unsigned& nx) {
  const unsigned G = gridDim.x * gridDim.y * gridDim.z;
  unsigned sum, cnt, mine, sp = 0u;
  for (;;) {
    sum = 0u; cnt = 0u; mine = 0u;
#pragma unroll
    for (unsigned j = 0; j < 16; ++j) { const unsigned c = xb_ld(&bar[XB_XCNT(j)]); sum += c; cnt += (c > 0u) ? 1u : 0u; mine = (j == x) ? c : mine; }
    if (sum == G) break;
    __builtin_amdgcn_s_sleep(1);
    if ((++sp & 255u) == 0u) { if (xb_ld(&bar[XB_TMO])) break; if (sp > XB_SPIN_CAP) { atomicAdd(&bar[XB_TMO], 1u); break; } }
  }
  nloc = mine > 0u ? mine : 1u; nx = cnt > 0u ? cnt : 1u;
}
DEVINL void xcd_barrier(const XcdBarrier& b) {
  asm volatile("s_waitcnt vmcnt(0)" ::: "memory");
  __syncthreads();
  if ((int)threadIdx.x == 0) {
    unsigned* bar = b.bar;
    __builtin_amdgcn_s_waitcnt(0);
    unsigned nloc = b.st[0], nx = b.st[1];
    if (nloc == 0u) { xcd_barrier_complete(bar, b.x, nloc, nx); b.st[0] = nloc; b.st[1] = nx; }
    const unsigned old = xb_add(&bar[XB_XSUB(b.x)], 1u);
    const unsigned gen = old / nloc;
    if (old + 1u == (gen + 1u) * nloc) {
      __builtin_amdgcn_fence(__ATOMIC_RELEASE, "agent");
      asm volatile("s_waitcnt vmcnt(0)" ::: "memory");
      const unsigned og = xb_add(&bar[XB_TOP], 1u);
      const unsigned tg = og / nx;
      if (og + 1u == (tg + 1u) * nx) xb_add(&bar[XB_TOPGEN], 1u);
      else XB_SPIN(xb_ld(&bar[XB_TOPGEN]) == tg, bar);
      __builtin_amdgcn_fence(__ATOMIC_ACQUIRE, "agent");
      xb_add(&bar[XB_XGEN(b.x)], 1u);
      asm volatile("s_waitcnt vmcnt(0)" ::: "memory");
    } else {
      XB_SPIN(xb_ld(&bar[XB_XGEN(b.x)]) == gen, bar);
      __builtin_amdgcn_fence(__ATOMIC_ACQUIRE, "agent");
      asm volatile("s_waitcnt vmcnt(0)" ::: "memory");
    }
  }
  __syncthreads();
}

namespace cg = cooperative_groups;
#define GSYNC() xcd_barrier(xb)
__global__ void __launch_bounds__(512, 2) fwd_megakernel(Params p) {
  cg::grid_group grid = cg::this_grid();
  const int half = threadIdx.x >> 8;
  const int bid = half * gridDim.x + blockIdx.x, nb = gridDim.x * 2;
  char* smem = g_smem + half * HALF_LDS;
  volatile unsigned* xst = (volatile unsigned*)(g_smem + XST_OFF);
  if (threadIdx.x < 4) xst[threadIdx.x] = 0u;
  if (threadIdx.x == 8 || threadIdx.x == 9) *(volatile unsigned*)(g_smem + HS_OFF + (threadIdx.x - 8) * 64) = 0u;
  __syncthreads();
  XcdBarrier xb = xcd_barrier_post((unsigned*)(p.ws + OFF_CTL), xst);
  phase_prep(p, bid, nb, smem);
  grid.sync();
  phase_norm(p, bid, nb, 0, 0, smem);
  GSYNC();
  phase8_inproj0(p);
  GSYNC();
  if (bid < 128) phase_s5_a(p, bid, 128, smem);
  else phase_moe_convert(p, bid - 128, nb - 128, 0, smem, 0, 6144);
  GSYNC();
  if (bid < 64) phase_s5_scan(p, bid, 64, smem);
  else { phase_moe_convert(p, bid - 64, nb - 64, 0, smem, 6144, 12288); phase_prep_l1(p, bid - 64, nb - 64, smem); }
  GSYNC();
  phase_s5_b(p, bid, nb, smem);
  phase_attn(p, bid, nb, smem);
  GSYNC();
  phase8_glu(p);
  GSYNC();
  phase8_outproj(p, 0);
  GSYNC();
  phase_norm_router(p, bid, nb, 0, smem);
  GSYNC();
  phase8_moe_gd(p, 0);
  GSYNC();
  phase_norm(p, bid, nb, 2, 1, smem);
  GSYNC();
  phase8_inproj1(p);
  GSYNC();
  if (bid < nb / 2) phase_m2_pre(p, bid, nb / 2, smem);
  else phase_rwkv_pre(p, bid - nb / 2, nb - nb / 2, smem);
  GSYNC();
  if (bid < nb / 2) phase_ssd_a(p, bid, nb / 2, smem);
  else { phase_rwkv_lora(p, bid - nb / 2, nb - nb / 2, 0, smem); phase_rwkv_lora(p, bid - nb / 2, nb - nb / 2, 1, smem); }
  GSYNC();
  if (nb >= 256) { if (bid < 128) phase_ssd_b(p, bid, 128, smem); }
  else phase_ssd_b(p, bid, nb, smem);
  phase_rwkv_chunk_a(p, bid, nb, smem);
  GSYNC();
  if (nb >= 512) { if (bid < 256) { __builtin_amdgcn_s_setprio(3); phase_rwkv_chunk_b(p, bid, 256, smem); __builtin_amdgcn_s_setprio(0); } }
  else phase_rwkv_chunk_b(p, bid, nb, smem);
  phase_ssd_c(p, bid, nb, smem);
  GSYNC();
  phase_rwkv_lora(p, bid, nb, 2, smem);
  GSYNC();
  phase8_outproj(p, 1);
  __syncthreads();
  phase_moe_convert(p, bid, nb, 1, smem);
  GSYNC();
  phase_norm_router(p, bid, nb, 1, smem);
  GSYNC();
  phase8_moe_gd(p, 1);
  GSYNC();
  phase_norm(p, bid, nb, 3, 1, smem);
}

extern "C" void kernel_launch(void* const* d_in, const int* in_sizes, int n_in, void* d_out, int out_size, void* d_ws, size_t ws_size,
                              hipStream_t stream) {
  constexpr size_t kDynLds = LDS_TOTAL;
  static int grid_blocks = 0;
  if (n_in != N_IN || ws_size < WS_NEEDED) { fprintf(stderr, "kernel_launch: bad n_in %d or ws_size %zu (need %zu)\n", n_in, ws_size, (size_t)WS_NEEDED); return; }
  if (!grid_blocks) {
    int dev = 0, cus = 0, per_cu = 0;
    (void)hipGetDevice(&dev);
    (void)hipDeviceGetAttribute(&cus, hipDeviceAttributeMultiprocessorCount, dev);
    (void)hipFuncSetAttribute((const void*)fwd_megakernel, hipFuncAttributeMaxDynamicSharedMemorySize, (int)kDynLds);
    (void)hipOccupancyMaxActiveBlocksPerMultiprocessor(&per_cu, fwd_megakernel, 512, kDynLds);
    if (per_cu > 1) per_cu = 1;
    if (per_cu < 1) per_cu = 1;
    grid_blocks = cus * per_cu;
    fprintf(stderr, "kernel_launch: cus %d per_cu %d grid %d\n", cus, per_cu, grid_blocks);
  }
  Params p{};
  for (int i = 0; i < N_IN; ++i) p.in[i] = (const float*)d_in[i];
  p.out = (float*)d_out;
  p.ws = (char*)d_ws;
  (void)hipMemsetAsync((char*)d_ws + OFF_CTL, 0, 65536, stream);
  void* args[] = {&p};
  hipError_t e = hipLaunchCooperativeKernel((void*)fwd_megakernel, dim3(grid_blocks), dim3(512), args, kDynLds, stream);
  if (e != hipSuccess) fprintf(stderr, "cooperative launch failed: %s (grid %d)\n", hipGetErrorString(e), grid_blocks);
}
```
